# Optimizing an MI355X kernel written in HIP

```python
import jax, jax.numpy as jnp
from jax import lax
import numpy as np

D_MODEL = 1024
BATCH = 4
SEQ = 8192
DEPTH = 1

SSD_HEADS = 16
SSD_HEAD_DIM = 64
SSD_WIDTH = SSD_HEADS * SSD_HEAD_DIM
SSD_GROUPS = 2
SSD_STATE = 128
SSD_CONV = 4
SSD_XBC_WIDTH = SSD_WIDTH + 2 * SSD_GROUPS * SSD_STATE
RET_HEADS = 8
RET_QK_DIM = 64
RET_V_DIM = 128
RET_QK_WIDTH = RET_HEADS * RET_QK_DIM
RET_V_WIDTH = RET_HEADS * RET_V_DIM
ROPE_BASE = 10000.0
CHUNK = 128
MIX_WIDTH = SSD_WIDTH + RET_V_WIDTH
IN_WIDTH = SSD_WIDTH + SSD_XBC_WIDTH + SSD_HEADS + 2 * RET_QK_WIDTH + 2 * RET_V_WIDTH
D_FF = 2816
FFN_CONV = 3
EPS = 1e-6

kernel_name = "hymba_ssd_retention_convffn_block"


def rmsnorm(x, w):
    xf = x.astype(jnp.float32)
    y = xf * lax.rsqrt(jnp.mean(xf * xf, axis=-1, keepdims=True) + EPS)
    return (y * w.astype(jnp.float32)).astype(x.dtype)


def causal_dwconv(x, w, b):
    k = w.shape[0]
    y = lax.conv_general_dilated(
        x, w[:, None, :].astype(x.dtype), window_strides=(1,), padding=[(k - 1, 0)],
        dimension_numbers=("NWC", "WIO", "NWC"), feature_group_count=x.shape[-1])
    return y + b.astype(x.dtype)


def rotary(t):
    s, d = t.shape[1], t.shape[-1]
    inv = ROPE_BASE ** (-jnp.arange(0, d, 2, dtype=jnp.float32) / d)
    ang = jnp.arange(s, dtype=jnp.float32)[:, None] * inv[None, :]
    cos = jnp.cos(ang)[None, :, None, :]
    sin = jnp.sin(ang)[None, :, None, :]
    tf = t.astype(jnp.float32)
    t1, t2 = jnp.split(tf, 2, axis=-1)
    return jnp.concatenate([t1 * cos - t2 * sin, t2 * cos + t1 * sin], axis=-1).astype(t.dtype)


def ssd_mixer(z, xbc, dt_raw, conv_w, conv_b, dt_bias, a_log, d_skip, norm_w):
    b, s, _ = z.shape
    nc = s // CHUNK
    hpg = SSD_HEADS // SSD_GROUPS
    xbc = jax.nn.silu(causal_dwconv(xbc, conv_w, conv_b))
    xs, bm, cm = jnp.split(xbc, [SSD_WIDTH, SSD_WIDTH + SSD_GROUPS * SSD_STATE], axis=-1)
    xs = xs.reshape(b, nc, CHUNK, SSD_GROUPS, hpg, SSD_HEAD_DIM)
    bm = bm.reshape(b, nc, CHUNK, SSD_GROUPS, SSD_STATE)
    cm = cm.reshape(b, nc, CHUNK, SSD_GROUPS, SSD_STATE)
    dt = jax.nn.softplus(dt_raw.astype(jnp.float32) + dt_bias.astype(jnp.float32))
    a = -jnp.exp(a_log.astype(jnp.float32))
    dt_c = dt.reshape(b, nc, CHUNK, SSD_GROUPS, hpg)
    da = jnp.transpose((dt * a).reshape(b, nc, CHUNK, SSD_GROUPS, hpg), (0, 1, 3, 4, 2))
    acs = jnp.cumsum(da, axis=-1)
    xdt = xs * dt_c[..., None].astype(xs.dtype)
    causal = jnp.tril(jnp.ones((CHUNK, CHUNK), dtype=bool))
    seg = acs[..., :, None] - acs[..., None, :]
    lmat = jnp.exp(jnp.where(causal, seg, -jnp.inf)).astype(xs.dtype)
    cb = jnp.einsum("bclgn,bcsgn->bcgls", cm, bm)
    y_diag = jnp.einsum("bcgkls,bcsgkp->bclgkp", cb[:, :, :, None] * lmat, xdt)
    decay_states = jnp.exp(acs[..., -1:] - acs).astype(xs.dtype)
    states = jnp.einsum("bclgn,bcgkl,bclgkp->bcgkpn", bm, decay_states, xdt)
    chunk_decay = jnp.exp(acs[..., -1]).astype(xs.dtype)

    def step(h, inp):
        st, dec = inp
        return (h * dec[..., None, None] + st).astype(h.dtype), h

    h0 = jnp.zeros_like(states[:, 0])
    _, prev = lax.scan(step, h0, (jnp.moveaxis(states, 1, 0), jnp.moveaxis(chunk_decay, 1, 0)))
    prev = jnp.moveaxis(prev, 0, 1)
    y_off = jnp.einsum("bclgn,bcgkpn,bcgkl->bclgkp", cm, prev, jnp.exp(acs).astype(xs.dtype))
    y = y_diag + y_off + xs * d_skip.reshape(SSD_GROUPS, hpg, 1).astype(xs.dtype)
    y = y.reshape(b, s, SSD_WIDTH)
    return rmsnorm(y * jax.nn.silu(z), norm_w)


def retention_mixer(q, k, v, g, norm_w):
    b, s, _ = q.shape
    nc = s // CHUNK
    q = rotary(q.reshape(b, s, RET_HEADS, RET_QK_DIM))
    k = rotary(k.reshape(b, s, RET_HEADS, RET_QK_DIM)) * (RET_QK_DIM ** -0.5)
    v = v.reshape(b, s, RET_HEADS, RET_V_DIM)
    log_gamma = jnp.log1p(-jnp.exp2(-5.0 - jnp.arange(RET_HEADS, dtype=jnp.float32)))
    pos = jnp.arange(CHUNK, dtype=jnp.float32)
    rel = pos[:, None] - pos[None, :]
    dmask = jnp.where(rel >= 0, jnp.exp(log_gamma[:, None, None] * jnp.maximum(rel, 0.0)), 0.0).astype(q.dtype)
    qc = q.reshape(b, nc, CHUNK, RET_HEADS, RET_QK_DIM)
    kc = k.reshape(b, nc, CHUNK, RET_HEADS, RET_QK_DIM)
    vc = v.reshape(b, nc, CHUNK, RET_HEADS, RET_V_DIM)
    scores = jnp.einsum("bclhd,bcshd->bchls", qc, kc) * dmask
    inner = jnp.einsum("bchls,bcshe->bclhe", scores, vc)
    k_decay = jnp.exp(log_gamma[:, None] * (CHUNK - 1 - pos)[None, :]).astype(q.dtype)
    chunk_kv = jnp.einsum("bclhd,hl,bclhe->bchde", kc, k_decay, vc)
    chunk_gamma = jnp.exp(log_gamma * CHUNK).astype(q.dtype)

    def step(r, kv):
        return (r * chunk_gamma[:, None, None] + kv).astype(r.dtype), r

    r0 = jnp.zeros_like(chunk_kv[:, 0])
    _, prev = lax.scan(step, r0, jnp.moveaxis(chunk_kv, 1, 0))
    prev = jnp.moveaxis(prev, 0, 1)
    q_decay = jnp.exp(log_gamma[:, None] * (pos + 1.0)[None, :]).astype(q.dtype)
    cross = jnp.einsum("bclhd,hl,bchde->bclhe", qc, q_decay, prev)
    o = (inner + cross).reshape(b, s, RET_HEADS, RET_V_DIM)
    of = o.astype(jnp.float32)
    of = of * lax.rsqrt(jnp.mean(of * of, axis=-1, keepdims=True) + EPS)
    o = (of.reshape(b, s, RET_V_WIDTH) * norm_w.astype(jnp.float32)).astype(q.dtype)
    return o * jax.nn.silu(g)


def setup_inputs(seed: int = 0) -> dict:
    key = jax.random.key(seed)
    ks = jax.random.split(key, 24)
    f32 = jnp.float32

    def nrm(k, shape, scale):
        return jax.random.normal(k, shape, f32) * scale

    def gain(k, shape):
        return 1.0 + 0.02 * jax.random.normal(k, shape, f32)

    dt0 = jnp.exp(jax.random.uniform(ks[6], (DEPTH, SSD_HEADS), f32, np.log(1e-3), np.log(1e-1)))
    return {
        "x": jax.random.normal(ks[0], (BATCH, SEQ, D_MODEL), f32),
        "pre_mix_norm_w": gain(ks[1], (DEPTH, D_MODEL)),
        "w_in": nrm(ks[2], (DEPTH, D_MODEL, IN_WIDTH), D_MODEL ** -0.5),
        "ssd_conv_w": nrm(ks[3], (DEPTH, SSD_CONV, SSD_XBC_WIDTH), SSD_CONV ** -0.5),
        "ssd_conv_b": nrm(ks[4], (DEPTH, SSD_XBC_WIDTH), 0.01),
        "ssd_dt_bias": dt0 + jnp.log(-jnp.expm1(-dt0)),
        "ssd_a_log": jnp.log(jax.random.uniform(ks[7], (DEPTH, SSD_HEADS), f32, 1.0, 16.0)),
        "ssd_d": gain(ks[8], (DEPTH, SSD_HEADS)),
        "ssd_norm_w": gain(ks[9], (DEPTH, SSD_WIDTH)),
        "ret_norm_w": gain(ks[10], (DEPTH, RET_V_WIDTH)),
        "w_out": nrm(ks[11], (DEPTH, MIX_WIDTH, D_MODEL), MIX_WIDTH ** -0.5),
        "post_mix_norm_w": gain(ks[12], (DEPTH, D_MODEL)),
        "pre_ffn_norm_w": gain(ks[13], (DEPTH, D_MODEL)),
        "w_up": nrm(ks[14], (DEPTH, D_MODEL, 2 * D_FF), D_MODEL ** -0.5),
        "ffn_conv_w": nrm(ks[15], (DEPTH, FFN_CONV, D_FF), FFN_CONV ** -0.5),
        "ffn_conv_b": nrm(ks[16], (DEPTH, D_FF), 0.01),
        "w_down": nrm(ks[17], (DEPTH, D_FF, D_MODEL), D_FF ** -0.5),
        "post_ffn_norm_w": gain(ks[18], (DEPTH, D_MODEL)),
    }


def reference(x, pre_mix_norm_w, w_in, ssd_conv_w, ssd_conv_b, ssd_dt_bias, ssd_a_log, ssd_d,
              ssd_norm_w, ret_norm_w, w_out, post_mix_norm_w, pre_ffn_norm_w, w_up,
              ffn_conv_w, ffn_conv_b, w_down, post_ffn_norm_w):
    splits = np.cumsum([SSD_WIDTH, SSD_XBC_WIDTH, SSD_HEADS, RET_QK_WIDTH, RET_QK_WIDTH, RET_V_WIDTH]).tolist()
    for l in range(DEPTH):
        h = rmsnorm(x, pre_mix_norm_w[l])
        proj = h @ w_in[l]
        z, xbc, dt_raw, q, k, v, g = jnp.split(proj, splits, axis=-1)
        y_ssd = ssd_mixer(z, xbc, dt_raw, ssd_conv_w[l], ssd_conv_b[l], ssd_dt_bias[l],
                          ssd_a_log[l], ssd_d[l], ssd_norm_w[l])
        y_ret = retention_mixer(q, k, v, g, ret_norm_w[l])
        y = jnp.concatenate([y_ssd, y_ret], axis=-1) @ w_out[l]
        x = x + rmsnorm(y, post_mix_norm_w[l])
        h = rmsnorm(x, pre_ffn_norm_w[l])
        gate, val = jnp.split(h @ w_up[l], 2, axis=-1)
        gate = causal_dwconv(gate, ffn_conv_w[l], ffn_conv_b[l])
        f = (jax.nn.silu(gate) * val) @ w_down[l]
        x = x + rmsnorm(f, post_ffn_norm_w[l])
    return x
```

```cpp
#include <hip/hip_runtime.h>
#include <hip/hip_cooperative_groups.h>
#include <cstdio>
#include <cstdint>
namespace cgrp = cooperative_groups;

namespace pg8 {
#define PG8_LAS __attribute__((address_space(3)))
typedef unsigned short bf16_t;
typedef short bf16x8 __attribute__((ext_vector_type(8)));
typedef float f32x4 __attribute__((ext_vector_type(4)));
typedef unsigned u32x4 __attribute__((ext_vector_type(4)));
constexpr int BM = 256, BK = 64, HALF = 128, HTB = HALF * BK * 2  , STAGE_BYTES = 8 * HTB, NXCD = 8, WGM = 8;

__host__ __device__ __forceinline__ int lds_byte(int r, int c) { const int st = (r >> 4) * 2 + (c >> 5), rr = r & 15, cc = c & 31, ob = rr * 64 + cc * 2; return st * 1024 + (ob ^ (((ob >> 9) & 1) << 5)); }
__host__ __device__ __forceinline__ void stage_rc(int b, int& R, int& C) { const int st = b / 1024, sb = b % 1024, swz = sb ^ (((sb >> 9) & 1) << 5); R = (st >> 1) * 16 + swz / 64; C = (st & 1) * 32 + (swz % 64) / 2; }
__host__ __device__ __forceinline__ int perm32(int rho) { const int n = rho >> 4, i = rho & 15; return 8 * (i >> 2) + 4 * n + (i & 3); }

struct Unit { int pm, pn; };
struct Gemm { const bf16_t* A; const bf16_t* Bt; int M, N, K, lda; };

struct StaticOrder {
    int nM, nN, nwg, G, c;
    __host__ __device__ void init(int M, int N, int G_, int c_) { nM = M / BM; nN = N / BM; nwg = nM * nN; G = G_; c = c_; }
    __host__ __device__ bool next(int i, Unit& u) const {
        const long L = (long)i * G + c; if (L >= nwg) return false;
        int wgid = (int)L; { const int q = nwg / NXCD, r = nwg % NXCD, xcd = wgid % NXCD, off = wgid / NXCD; wgid = (xcd < r ? xcd * (q + 1) : r * (q + 1) + (xcd - r) * q) + off; }
        const int nig = WGM * nN, gid = wgid / nig, fm = gid * WGM, gsz = (nM - fm) < WGM ? (nM - fm) : WGM;
        u.pm = fm + ((wgid % nig) % gsz); u.pn = (wgid % nig) / gsz; return true;
    }
    __device__ __forceinline__ void a_ready(const Unit&) const {}
    __device__ __forceinline__ void done(const Unit&) const {}
};

__device__ __forceinline__ unsigned cvt_pk_bf16(float lo, float hi) { unsigned r; asm volatile("v_cvt_pk_bf16_f32 %0, %1, %2" : "=v"(r) : "v"(lo), "v"(hi)); return r; }
struct EpiBf16 {
    static constexpr bool PERM = true, AFTER_DRAIN = false;
    bf16_t* O; int ldc;
    __device__ __forceinline__ void operator()(const f32x4 (&acc)[2][2][4][2], const Unit& u, int wr, int wc, int fr, int fq) const {
        const int row0 = u.pm * BM + wr * 64 + fr, col0 = u.pn * BM + wc * 32 + 8 * fq;
#pragma unroll
        for (int ai = 0; ai < 2; ++ai)
#pragma unroll
            for (int m = 0; m < 4; ++m) { bf16_t* rowp = O + (size_t)(row0 + ai * HALF + m * 16) * ldc + col0;
#pragma unroll
                for (int bj = 0; bj < 2; ++bj) { const f32x4 v0 = acc[ai][bj][m][0], v1 = acc[ai][bj][m][1];
                    u32x4 w; w.x = cvt_pk_bf16(v0[0], v0[1]); w.y = cvt_pk_bf16(v0[2], v0[3]); w.z = cvt_pk_bf16(v1[0], v1[1]); w.w = cvt_pk_bf16(v1[2], v1[3]);
                    *(u32x4*)(rowp + bj * HALF) = w; } }
    }
};
struct EpiProj {
    static constexpr bool PERM = true, AFTER_DRAIN = false;
    bf16_t* O; float* DT;
    __device__ __forceinline__ void operator()(const f32x4 (&acc)[2][2][4][2], const Unit& u, int wr, int wc, int fr, int fq) const {
        const int row0 = u.pm * BM + wr * 64 + fr;
        if (u.pn < 22) {
            const int col0 = u.pn * BM + wc * 32 + 8 * fq;
#pragma unroll
            for (int ai = 0; ai < 2; ++ai)
#pragma unroll
                for (int m = 0; m < 4; ++m) { bf16_t* rowp = O + (size_t)(row0 + ai * HALF + m * 16) * 5632 + col0;
#pragma unroll
                    for (int bj = 0; bj < 2; ++bj) { const f32x4 v0 = acc[ai][bj][m][0], v1 = acc[ai][bj][m][1];
                        u32x4 w; w.x = cvt_pk_bf16(v0[0], v0[1]); w.y = cvt_pk_bf16(v0[2], v0[3]); w.z = cvt_pk_bf16(v1[0], v1[1]); w.w = cvt_pk_bf16(v1[2], v1[3]);
                        *(u32x4*)(rowp + bj * HALF) = w; } }
        } else if (wc == 0 && fq < 2) {
#pragma unroll
            for (int ai = 0; ai < 2; ++ai)
#pragma unroll
                for (int m = 0; m < 4; ++m) { float* p = DT + (size_t)(row0 + ai * HALF + m * 16) * 16 + 8 * fq;
                    *(f32x4*)p = acc[ai][0][m][0]; *(f32x4*)(p + 4) = acc[ai][0][m][1]; }
        }
    }
};
struct EpiF32 {
    static constexpr bool PERM = true, AFTER_DRAIN = false;
    float* O; int ldc;
    __device__ __forceinline__ void operator()(const f32x4 (&acc)[2][2][4][2], const Unit& u, int wr, int wc, int fr, int fq) const {
        const int row0 = u.pm * BM + wr * 64 + fr, col0 = u.pn * BM + wc * 32 + 8 * fq;
#pragma unroll
        for (int ai = 0; ai < 2; ++ai)
#pragma unroll
            for (int m = 0; m < 4; ++m) { float* rowp = O + (size_t)(row0 + ai * HALF + m * 16) * ldc + col0;
#pragma unroll
                for (int bj = 0; bj < 2; ++bj) { *(f32x4*)(rowp + bj * HALF) = acc[ai][bj][m][0]; *(f32x4*)(rowp + bj * HALF + 4) = acc[ai][bj][m][1]; } }
    }
};
template <class Epi, class Sched, bool ALIGN_EPI = false, bool SP2 = false>
__device__ __forceinline__ void gemm_phase(PG8_LAS unsigned char* lds, const Gemm g, const Sched& S, const Epi& E) {
    const int tid = threadIdx.x, wid = __builtin_amdgcn_readfirstlane(tid >> 6), lane = tid & 63, wr = wid >> 2, wc = wid & 3, fr = lane & 15, fq = lane >> 4;
    const int K = g.K, nt = K / BK;
    unsigned voffA[2], voffB[2];
#pragma unroll
    for (int i = 0; i < 2; ++i) { int R, C; stage_rc(tid * 16 + i * 8192, R, C); const int Rb = Epi::PERM ? ((R & ~31) + perm32(R & 31)) : R;
        voffA[i] = (unsigned)(R * g.lda + C) * 2u; voffB[i] = (unsigned)(Rb * K + C) * 2u; }
    const size_t kstep = (size_t)(BK * 2);
    const size_t hstepA = (size_t)HALF * g.lda * 2, hstepB = (size_t)HALF * K * 2;
    const size_t tstepA = 2 * hstepA, tstepB = 2 * hstepB;
    const unsigned ldsw = (unsigned)wid * 1024u;
    const int aoff = lds_byte(wr * 64 + fr, fq * 8), boff = lds_byte(wc * 32 + fr, fq * 8);
#define PG8_SA(b, h) (((b) * 2 + (h)) * HTB)
#define PG8_SB(b, h) ((4 + (b) * 2 + (h)) * HTB)
#define PG8_STAGE(bufoff, gbase, voff) do { _Pragma("unroll") for (int _i = 0; _i < 2; ++_i) \
        __builtin_amdgcn_global_load_lds((const unsigned*)((const char*)(gbase) + (voff)[_i]), (PG8_LAS unsigned*)(lds + (bufoff) + ldsw + _i * 8192), 16, 0, 0); } while (0)
#define PG8_LDA(dst, b, h) do { _Pragma("unroll") for (int m = 0; m < 4; ++m) _Pragma("unroll") for (int k = 0; k < 2; ++k) dst[m][k] = *(const PG8_LAS bf16x8*)(lds + PG8_SA(b, h) + aoff + m * 2048 + k * 1024); } while (0)
#define PG8_LDB(dst, b, h) do { _Pragma("unroll") for (int n = 0; n < 2; ++n) _Pragma("unroll") for (int k = 0; k < 2; ++k) dst[n][k] = *(const PG8_LAS bf16x8*)(lds + PG8_SB(b, h) + boff + n * 2048 + k * 1024); } while (0)
#define PG8_MMA(ai, bj, At, Bt) do { __builtin_amdgcn_s_setprio(1); _Pragma("unroll") for (int m = 0; m < 4; ++m) _Pragma("unroll") for (int n = 0; n < 2; ++n) _Pragma("unroll") for (int k = 0; k < 2; ++k) \
        acc[ai][bj][m][n] = __builtin_amdgcn_mfma_f32_16x16x32_bf16(Bt[n][k], At[m][k], acc[ai][bj][m][n], 0, 0, 0); __builtin_amdgcn_s_setprio(0); } while (0)
#define PG8_WAIT_V(n) asm volatile("s_waitcnt vmcnt(" #n ")" ::: "memory")
#define PG8_WAIT_L(n) asm volatile("s_waitcnt lgkmcnt(" #n ")" ::: "memory")
#define PG8_BAR __builtin_amdgcn_s_barrier()
#define PG8_SCHED __builtin_amdgcn_sched_barrier(0)
    Unit cur, nxt; int ui = 0;
    if (!S.next(0, cur)) return;
    f32x4 acc[2][2][4][2];
#pragma unroll
    for (int a = 0; a < 2; ++a)
#pragma unroll
        for (int b = 0; b < 2; ++b)
#pragma unroll
            for (int m = 0; m < 4; ++m)
#pragma unroll
                for (int n = 0; n < 2; ++n) acc[a][b][m][n] = (f32x4){0.f, 0.f, 0.f, 0.f};
    bf16x8 At[4][2], B0[2][2], B1[2][2];
    const char* cA = (const char*)g.A + (size_t)cur.pm * tstepA; const char* cB = (const char*)g.Bt + (size_t)cur.pn * tstepB;
    S.a_ready(cur);
    if constexpr (SP2) {
        PG8_STAGE(PG8_SB(0, 0), cB, voffB); PG8_STAGE(PG8_SB(0, 1), cB + hstepB, voffB); PG8_STAGE(PG8_SA(0, 0), cA, voffA); PG8_STAGE(PG8_SA(0, 1), cA + hstepA, voffA);
        if (wr == 1) PG8_BAR;
        PG8_WAIT_V(2); PG8_BAR;
        PG8_STAGE(PG8_SB(1, 0), cB + kstep, voffB); PG8_STAGE(PG8_SA(1, 0), cA + kstep, voffA); PG8_STAGE(PG8_SB(1, 1), cB + hstepB + kstep, voffB);
        PG8_WAIT_V(6); PG8_BAR;
    } else {
        PG8_STAGE(PG8_SB(0, 0), cB, voffB); PG8_STAGE(PG8_SA(0, 0), cA, voffA); PG8_STAGE(PG8_SB(0, 1), cB + hstepB, voffB); PG8_STAGE(PG8_SA(0, 1), cA + hstepA, voffA);
        if (wr == 1) PG8_BAR;
        PG8_WAIT_V(4); PG8_BAR;
        PG8_STAGE(PG8_SB(1, 0), cB + kstep, voffB); PG8_STAGE(PG8_SA(1, 0), cA + kstep, voffA); PG8_STAGE(PG8_SB(1, 1), cB + hstepB + kstep, voffB);
        PG8_WAIT_V(6); PG8_BAR;
    }
    for (;;) {
        const bool has_next = S.next(ui + 1, nxt);
        const char* nA = has_next ? (const char*)g.A + (size_t)nxt.pm * tstepA : cA; const char* nB = has_next ? (const char*)g.Bt + (size_t)nxt.pn * tstepB : cB;
        for (int t = 0; t < nt; t += 2) {
            const bool last = (t == nt - 2);
            const char* a1 = cA + (size_t)(t + 1) * kstep;
            const char* a2 = last ? nA : cA + (size_t)(t + 2) * kstep; const char* b2 = last ? nB : cB + (size_t)(t + 2) * kstep;
            const char* a3 = a2 + kstep; const char* b3 = b2 + kstep;
            if (last && has_next) S.a_ready(nxt);
            if constexpr (SP2) {
            PG8_LDB(B0, 0, 0); PG8_LDB(B1, 0, 1); PG8_SCHED; PG8_LDA(At, 0, 0); PG8_STAGE(PG8_SA(1, 1), a1 + hstepA, voffA);
            PG8_WAIT_V(8); PG8_WAIT_L(0); PG8_BAR; PG8_MMA(0, 0, At, B0); PG8_MMA(0, 1, At, B1); PG8_BAR; PG8_SCHED;
            PG8_LDA(At, 0, 1); PG8_STAGE(PG8_SB(0, 0), b2, voffB); PG8_STAGE(PG8_SB(0, 1), b2 + hstepB, voffB); PG8_STAGE(PG8_SA(0, 0), a2, voffA);
            PG8_WAIT_V(8); PG8_WAIT_L(0); PG8_BAR; PG8_MMA(1, 0, At, B0); PG8_MMA(1, 1, At, B1); PG8_BAR; PG8_SCHED;
            PG8_LDB(B0, 1, 0); PG8_LDB(B1, 1, 1); PG8_SCHED; PG8_LDA(At, 1, 0); PG8_STAGE(PG8_SA(0, 1), a2 + hstepA, voffA);
            PG8_WAIT_V(8); PG8_WAIT_L(0); PG8_BAR; PG8_MMA(0, 0, At, B0); PG8_MMA(0, 1, At, B1); PG8_BAR; PG8_SCHED;
            PG8_LDA(At, 1, 1); PG8_STAGE(PG8_SB(1, 0), b3, voffB); PG8_STAGE(PG8_SB(1, 1), b3 + hstepB, voffB); PG8_STAGE(PG8_SA(1, 0), a3, voffA);
            PG8_WAIT_V(8); PG8_WAIT_L(0); PG8_BAR; PG8_MMA(1, 0, At, B0); PG8_MMA(1, 1, At, B1); PG8_BAR; PG8_SCHED;
            } else {
            PG8_LDB(B0, 0, 0); PG8_SCHED; PG8_LDA(At, 0, 0); PG8_STAGE(PG8_SA(1, 1), a1 + hstepA, voffA);
            PG8_WAIT_L(8); PG8_BAR; PG8_WAIT_L(0); PG8_MMA(0, 0, At, B0); PG8_BAR; PG8_SCHED;
            PG8_LDB(B1, 0, 1); PG8_STAGE(PG8_SB(0, 0), b2, voffB);
            PG8_BAR; PG8_WAIT_L(0); PG8_MMA(0, 1, At, B1); PG8_BAR;
            PG8_LDA(At, 0, 1); PG8_STAGE(PG8_SA(0, 0), a2, voffA);
            PG8_BAR; PG8_WAIT_L(0); PG8_MMA(1, 0, At, B0); PG8_BAR; PG8_SCHED;
            PG8_STAGE(PG8_SB(0, 1), b2 + hstepB, voffB);
            PG8_WAIT_V(6); PG8_BAR; PG8_MMA(1, 1, At, B1); PG8_BAR;
            PG8_LDB(B0, 1, 0); PG8_SCHED; PG8_LDA(At, 1, 0); PG8_STAGE(PG8_SA(0, 1), a2 + hstepA, voffA);
            PG8_WAIT_L(8); PG8_BAR; PG8_WAIT_L(0); PG8_MMA(0, 0, At, B0); PG8_BAR; PG8_SCHED;
            PG8_LDB(B1, 1, 1); PG8_STAGE(PG8_SB(1, 0), b3, voffB);
            PG8_BAR; PG8_WAIT_L(0); PG8_MMA(0, 1, At, B1); PG8_BAR;
            PG8_LDA(At, 1, 1); PG8_STAGE(PG8_SA(1, 0), a3, voffA);
            PG8_BAR; PG8_WAIT_L(0); PG8_MMA(1, 0, At, B0); PG8_BAR; PG8_SCHED;
            PG8_STAGE(PG8_SB(1, 1), b3 + hstepB, voffB);
            PG8_WAIT_V(6); PG8_BAR; PG8_MMA(1, 1, At, B1); PG8_BAR;
            }
        }
        if constexpr (ALIGN_EPI) { if (wr == 0) PG8_BAR; }
        if constexpr (!Epi::AFTER_DRAIN) { E(acc, cur, wr, wc, fr, fq); S.done(cur); }
        if (!has_next) break;
#pragma unroll
        for (int a = 0; a < 2; ++a)
#pragma unroll
            for (int b = 0; b < 2; ++b)
#pragma unroll
                for (int m = 0; m < 4; ++m)
#pragma unroll
                    for (int n = 0; n < 2; ++n) acc[a][b][m][n] = (f32x4){0.f, 0.f, 0.f, 0.f};
        cur = nxt; cA = nA; cB = nB; ++ui;
        if constexpr (ALIGN_EPI) { if (wr == 1) PG8_BAR; }
    }
    PG8_WAIT_V(0);
    if constexpr (!ALIGN_EPI) { if (wr == 0) PG8_BAR; }
    PG8_BAR;
    if constexpr (Epi::AFTER_DRAIN) { E.fused(acc, cur, wr, wc, fr, fq, lds, wid, lane); S.done(cur); }
#undef PG8_SA
#undef PG8_SB
#undef PG8_STAGE
#undef PG8_LDA
#undef PG8_LDB
#undef PG8_MMA
#undef PG8_WAIT_V
#undef PG8_WAIT_L
#undef PG8_BAR
#undef PG8_SCHED
}
}

#define LAS __attribute__((address_space(3)))
#define DI __device__ __forceinline__
typedef unsigned short bf16;
typedef short bf16x8 __attribute__((ext_vector_type(8)));
typedef short s16x4 __attribute__((ext_vector_type(4)));
typedef float f32x4 __attribute__((ext_vector_type(4)));
typedef float f32x16 __attribute__((ext_vector_type(16)));
typedef unsigned u32x4 __attribute__((ext_vector_type(4)));
typedef unsigned u32x2 __attribute__((ext_vector_type(2)));

constexpr int T_TOK = 32768, DM = 1024, NCHUNK = 256;
constexpr int LDP = 5632;
constexpr int NINP = 5888;
constexpr int DFF = 2816, LDU = 5632;
constexpr int PC_Z = 0, PC_X = 1024, PC_B = 2048, PC_C = 2304, PC_Q = 2560, PC_K = 3072, PC_V = 3584, PC_G = 4608;
constexpr float EPS = 1e-6f;
constexpr size_t MiB = 1u << 20;
constexpr size_t WS_R1 = 1 * MiB;
constexpr size_t WS_BIG = 97 * MiB;
constexpr size_t WS_WIN = 449 * MiB;
constexpr size_t WS_WOUT = WS_WIN + (size_t)NINP * 1024 * 2;
constexpr size_t WS_WUP = WS_WOUT + (size_t)1024 * 2048 * 2;
constexpr size_t WS_WDN = WS_WUP + (size_t)5632 * 1024 * 2;
constexpr size_t WS_DT = 481 * MiB;
constexpr size_t WS_CD = 483 * MiB;
constexpr size_t WS_END = 484 * MiB;
static_assert(WS_WDN + (size_t)1024 * 2816 * 2 <= WS_DT, "ws map");
constexpr size_t STS_BYTES = (size_t)256 * 16 * 8192 * 2;
constexpr int LDS_BYTES = 155648;
constexpr int NTHR = 512;

struct Args { const float* in[18]; float* out; unsigned char* ws; int ph_lo, ph_hi; };

DI float bf2f(unsigned v) { return __uint_as_float(v << 16); }
DI unsigned cvtpk(float lo, float hi) { unsigned r; asm("v_cvt_pk_bf16_f32 %0, %1, %2" : "=v"(r) : "v"(lo), "v"(hi)); return r; }
DI bf16 f2bf(float f) { return (bf16)(cvtpk(f, 0.f) & 0xffffu); }
DI void unpack8(const u32x4 v, float (&f)[8]) {
    f[0] = __uint_as_float(v.x << 16); f[1] = __uint_as_float(v.x & 0xffff0000u); f[2] = __uint_as_float(v.y << 16); f[3] = __uint_as_float(v.y & 0xffff0000u);
    f[4] = __uint_as_float(v.z << 16); f[5] = __uint_as_float(v.z & 0xffff0000u); f[6] = __uint_as_float(v.w << 16); f[7] = __uint_as_float(v.w & 0xffff0000u);
}
DI u32x4 pack8(const float (&f)[8]) { u32x4 w; w.x = cvtpk(f[0], f[1]); w.y = cvtpk(f[2], f[3]); w.z = cvtpk(f[4], f[5]); w.w = cvtpk(f[6], f[7]); return w; }
DI float silu(float x) { return x / (1.f + __expf(-x)); }
DI float softplus(float x) { return fmaxf(x, 0.f) + log1pf(__expf(-fabsf(x))); }
DI float wave_sum(float v) {
#pragma unroll
    for (int o = 1; o < 64; o <<= 1) v += __shfl_xor(v, o);
    return v;
}
DI float half_sum32(float v) {
#pragma unroll
    for (int o = 1; o < 32; o <<= 1) v += __shfl_xor(v, o);
    return v;
}
DI int crow(int reg, int h) { return (reg & 3) + 8 * (reg >> 2) + 4 * h; }
DI float ret_lg(int h) { return log1pf(-exp2f(-5.f - (float)h)); }

typedef short v4i16_t __attribute__((ext_vector_type(4)));
DI bf16x8 frag_row(const LAS bf16* T, int ld, int row0, int k0, int lane) {
    return *(const LAS bf16x8*)(T + (row0 + (lane & 31)) * ld + k0 + 8 * (lane >> 5));
}
DI bf16x8 frag_tr(const LAS bf16* T, int ld, int row0, int k0, int lane) {
    const int h = lane >> 5, blk = (lane >> 4) & 1, q = (lane & 15) >> 2, p = lane & 3;
    const LAS bf16* a = T + (k0 + 8 * h + q) * ld + row0 + 16 * blk + 4 * p;
    const v4i16_t lo = __builtin_amdgcn_ds_read_tr16_b64_v4i16((LAS v4i16_t*)a);
    const v4i16_t hi = __builtin_amdgcn_ds_read_tr16_b64_v4i16((LAS v4i16_t*)(a + 4 * ld));
    return __builtin_shufflevector(lo, hi, 0, 1, 2, 3, 4, 5, 6, 7);
}
template <int NT, bool A_TR, bool B_TR>
DI void mma_tile(f32x16 (&acc)[NT], const LAS bf16* A, int lda, int arow0, const LAS bf16* B, int ldb, int brow0, int K, int lane) {
#pragma unroll 2
    for (int k0 = 0; k0 < K; k0 += 16) {
        const bf16x8 a = A_TR ? frag_tr(A, lda, arow0, k0, lane) : frag_row(A, lda, arow0, k0, lane);
#pragma unroll
        for (int nt = 0; nt < NT; ++nt) {
            const bf16x8 b = B_TR ? frag_tr(B, ldb, brow0 + 32 * nt, k0, lane) : frag_row(B, ldb, brow0 + 32 * nt, k0, lane);
            acc[nt] = __builtin_amdgcn_mfma_f32_32x32x16_bf16(a, b, acc[nt], 0, 0, 0);
        }
    }
}
DI void zero16(f32x16& a) {
#pragma unroll
    for (int i = 0; i < 16; ++i) a[i] = 0.f;
}

DI void transpose_item(const float* W, int K, int N, bf16* WT, int mode, LAS float* scr, int item, int lane) {
    const int Ndst = mode == 1 ? NINP : N;
    const int nblk = Ndst / 32, kb = item / nblk, nb = item % nblk, k0 = 64 * kb, n0 = 32 * nb;
    const int nd = n0 + (lane & 31); int ns = nd; bool valid = true;
    if (mode == 1) { if (nd < 2560) ns = nd; else if (nd < 5632) ns = nd + 16; else if (nd < 5648) ns = nd - 5632 + 2560; else { valid = false; ns = 0; } }
#pragma unroll 8
    for (int i = 0; i < 32; ++i) { const int kk = 2 * i + (lane >> 5); scr[kk * 33 + (lane & 31)] = valid ? W[(size_t)(k0 + kk) * N + ns] : 0.f; }
    asm volatile("s_waitcnt lgkmcnt(0)" ::: "memory");
    const int c = lane & 7;
#pragma unroll
    for (int j = 0; j < 4; ++j) { const int n = (lane >> 3) + 8 * j; const LAS float* s = scr + (8 * c) * 33 + n;
        u32x4 o; o.x = cvtpk(s[0 * 33], s[1 * 33]); o.y = cvtpk(s[2 * 33], s[3 * 33]); o.z = cvtpk(s[4 * 33], s[5 * 33]); o.w = cvtpk(s[6 * 33], s[7 * 33]);
        *(u32x4*)(WT + (size_t)(n0 + n) * K + k0 + 8 * c) = o; }
    asm volatile("s_waitcnt lgkmcnt(0)" ::: "memory");
}
DI void p0_prologue(const Args& a, LAS unsigned char* lds, int wave, int lane) {
    unsigned char* ws = a.ws;
    LAS float* scr = (LAS float*)(lds + wave * 16384);
    const int gw = blockIdx.x * 8 + wave, NGW = gridDim.x * 8;
    constexpr int I_IN = 16 * (NINP / 32), I_OUT = 32 * 32, I_UP = 16 * 176, I_DN = 44 * 32;
    for (int it = gw; it < I_IN + I_OUT + I_UP + I_DN; it += NGW) {
        int r = it;
        if (r < I_IN) { transpose_item(a.in[2], 1024, 5648, (bf16*)(ws + WS_WIN), 1, scr, r, lane); continue; } r -= I_IN;
        if (r < I_OUT) { transpose_item(a.in[10], 2048, 1024, (bf16*)(ws + WS_WOUT), 0, scr, r, lane); continue; } r -= I_OUT;
        if (r < I_UP) { transpose_item(a.in[13], 1024, 5632, (bf16*)(ws + WS_WUP), 0, scr, r, lane); continue; } r -= I_UP;
        transpose_item(a.in[16], 2816, 1024, (bf16*)(ws + WS_WDN), 0, scr, r, lane);
    }
    const float* x = a.in[0]; const f32x4* w4 = (const f32x4*)a.in[1]; bf16* H = (bf16*)(ws + WS_R1);
    f32x4 wv[4];
#pragma unroll
    for (int j = 0; j < 4; ++j) wv[j] = w4[lane + 64 * j];
    for (int m = gw; m < T_TOK; m += NGW) {
        const f32x4* xr = (const f32x4*)(x + (size_t)m * DM) + lane;
        f32x4 v[4]; float s = 0.f;
#pragma unroll
        for (int j = 0; j < 4; ++j) { v[j] = xr[64 * j]; s += (v[j].x * v[j].x + v[j].y * v[j].y) + (v[j].z * v[j].z + v[j].w * v[j].w); }
        const float rstd = rsqrtf(wave_sum(s) * (1.f / DM) + EPS);
        u32x2* o = (u32x2*)(H + (size_t)m * DM) + lane;
#pragma unroll
        for (int j = 0; j < 4; ++j) { u32x2 w; w.x = cvtpk(v[j].x * rstd * wv[j].x, v[j].y * rstd * wv[j].y); w.y = cvtpk(v[j].z * rstd * wv[j].z, v[j].w * rstd * wv[j].w); o[64 * j] = w; }
    }
}

DI void ssd_conv8(const bf16* PROJ, const float* cw, const float* cb, int trow, int pos, int pcol, int xc, float (&o)[8]) {
    const f32x4 b0 = *(const f32x4*)(cb + xc), b1 = *(const f32x4*)(cb + xc + 4);
    float acc[8] = {b0.x, b0.y, b0.z, b0.w, b1.x, b1.y, b1.z, b1.w};
#pragma unroll
    for (int j = 0; j < 4; ++j) {
        if (pos - 3 + j >= 0) {
            const u32x4 v = *(const u32x4*)(PROJ + (size_t)(trow - 3 + j) * LDP + pcol);
            const f32x4 w0 = *(const f32x4*)(cw + j * 1536 + xc), w1 = *(const f32x4*)(cw + j * 1536 + xc + 4);
            float f[8]; unpack8(v, f);
            acc[0] += w0.x * f[0]; acc[1] += w0.y * f[1]; acc[2] += w0.z * f[2]; acc[3] += w0.w * f[3];
            acc[4] += w1.x * f[4]; acc[5] += w1.y * f[5]; acc[6] += w1.z * f[6]; acc[7] += w1.w * f[7];
        }
    }
#pragma unroll
    for (int e = 0; e < 8; ++e) o[e] = silu(acc[e]);
}
DI void rotary8(const u32x4 v1, const u32x4 v2, int pos, int dg, float scale, u32x4& o1, u32x4& o2) {
    float a[8], b[8], r1[8], r2[8]; unpack8(v1, a); unpack8(v2, b);
#pragma unroll
    for (int e = 0; e < 8; ++e) {
        const float inv = exp2f(-(float)(dg + e) * 0.41524101186092f);
        const float ang = (float)pos * inv;
        const float n = rintf(ang * 0.15915494309189535f);
        float r = fmaf(-n, 6.28125f, ang); r = fmaf(-n, 1.9353071795864769e-3f, r);
        const float sn = __sinf(r), cs = __cosf(r);
        r1[e] = (a[e] * cs - b[e] * sn) * scale; r2[e] = (b[e] * cs + a[e] * sn) * scale;
    }
    o1 = pack8(r1); o2 = pack8(r2);
}
DI void chunk_prep(const Args& a, const float* DT, int bc, LAS float* dtl, LAS float* acs, int wave, int lane) {
    const int t0 = bc * 128;
#pragma unroll
    for (int hh = 0; hh < 2; ++hh) {
        const int h = 2 * wave + hh, l0 = 2 * lane;
        const float bias = a.in[5][h], av = -expf(a.in[6][h]);
        const float d0 = softplus(DT[(size_t)(t0 + l0) * 16 + h] + bias), d1 = softplus(DT[(size_t)(t0 + l0 + 1) * 16 + h] + bias);
        const float x0 = d0 * av, x1 = x0 + d1 * av;
        float s = x1;
#pragma unroll
        for (int off = 1; off < 64; off <<= 1) { const float v = __shfl_up(s, off); if (lane >= off) s += v; }
        const float ex = s - x1;
        acs[h * 128 + l0] = ex + x0; acs[h * 128 + l0 + 1] = ex + x1; dtl[h * 128 + l0] = d0; dtl[h * 128 + l0 + 1] = d1;
    }
}

DI void p2_chunk(const Args& a, LAS unsigned char* lds, int bc, int tid, int wave, int lane) {
    unsigned char* ws = a.ws;
    const bf16* PROJ = (const bf16*)(ws + WS_BIG); const float* DT = (const float*)(ws + WS_DT); float* CD = (float*)(ws + WS_CD);
    bf16* STS = (bf16*)(ws + WS_R1); bf16* STR = (bf16*)(ws + WS_R1 + STS_BYTES);
    LAS float* dtl = (LAS float*)lds; LAS float* acs = (LAS float*)(lds + 8192);
    LAS bf16* T1 = (LAS bf16*)(lds + 16384);
    LAS bf16* T2 = (LAS bf16*)(lds + 16384 + 73728);
    const int t0 = bc * 128, pos0 = (bc & 63) * 128;
    __syncthreads();
    chunk_prep(a, DT, bc, dtl, acs, wave, lane);
    __syncthreads();
    if (tid < 16) CD[bc * 16 + tid] = __expf(acs[tid * 128 + 127]);
    const float* cw = a.in[3]; const float* cb = a.in[4];
    for (int g = 0; g < 2; ++g) {
#pragma unroll 1
        for (int r = 0; r < 4; ++r) { const int it = tid + NTHR * r, l = it >> 4, c8 = (it & 15) * 8; float o[8];
            ssd_conv8(PROJ, cw, cb, t0 + l, pos0 + l, PC_B + g * 128 + c8, 1024 + g * 128 + c8, o);
            *(LAS u32x4*)(T2 + l * 160 + c8) = pack8(o); }
        for (int hh = 0; hh < 2; ++hh) {
#pragma unroll 1
            for (int r = 0; r < 8; ++r) { const int it = tid + NTHR * r, l = it >> 5, col = (it & 31) * 8, h = g * 8 + hh * 4 + (col >> 6), xc = h * 64 + (col & 63); float o[8];
                ssd_conv8(PROJ, cw, cb, t0 + l, pos0 + l, PC_X + xc, xc, o);
                const float sc = dtl[h * 128 + l] * __expf(acs[h * 128 + 127] - acs[h * 128 + l]);
#pragma unroll
                for (int e = 0; e < 8; ++e) o[e] *= sc;
                *(LAS u32x4*)(T1 + l * 288 + col) = pack8(o); }
            __syncthreads();
            f32x16 acc[4];
#pragma unroll
            for (int nt = 0; nt < 4; ++nt) zero16(acc[nt]);
            mma_tile<4, true, true>(acc, T1, 288, wave * 32, T2, 160, 0, 128, lane);
            { const int h = g * 8 + hh * 4 + (wave >> 1); bf16* S = STS + (size_t)(bc * 16 + h) * 8192;
#pragma unroll
              for (int nt = 0; nt < 4; ++nt)
#pragma unroll
                for (int reg = 0; reg < 16; ++reg) { const int p = (wave & 1) * 32 + crow(reg, lane >> 5), n = nt * 32 + (lane & 31); S[p * 128 + n] = f2bf(acc[nt][reg]); } }
            __syncthreads();
        }
    }
    for (int hp = 0; hp < 4; ++hp) {
#pragma unroll 1
        for (int r = 0; r < 8; ++r) { const int it = tid + NTHR * r, l = it >> 5, col = (it & 31) * 8;
            *(LAS u32x4*)(T1 + l * 288 + col) = *(const u32x4*)(PROJ + (size_t)(t0 + l) * LDP + PC_V + hp * 256 + col); }
#pragma unroll 1
        for (int r = 0; r < 2; ++r) { const int it = tid + NTHR * r, l = it >> 3, i = (it >> 2) & 1, dg = (it & 3) * 8, h = 2 * hp + i;
            const bf16* kp = PROJ + (size_t)(t0 + l) * LDP + PC_K + h * 64 + dg;
            const u32x4 k1 = *(const u32x4*)kp, k2 = *(const u32x4*)(kp + 32); u32x4 o1, o2;
            rotary8(k1, k2, pos0 + l, dg, 0.125f * __expf(ret_lg(h) * (float)(127 - l)), o1, o2);
            *(LAS u32x4*)(T2 + l * 160 + i * 64 + dg) = o1; *(LAS u32x4*)(T2 + l * 160 + i * 64 + 32 + dg) = o2; }
        __syncthreads();
        f32x16 acc[2]; zero16(acc[0]); zero16(acc[1]);
        const int i = wave >> 2;
        mma_tile<2, true, true>(acc, T1, 288, i * 128 + (wave & 3) * 32, T2, 160, i * 64, 128, lane);
        { bf16* S = STR + (size_t)(bc * 8 + 2 * hp + i) * 8192;
#pragma unroll
          for (int nt = 0; nt < 2; ++nt)
#pragma unroll
            for (int reg = 0; reg < 16; ++reg) { const int e = (wave & 3) * 32 + crow(reg, lane >> 5), d = nt * 32 + (lane & 31); S[e * 64 + d] = f2bf(acc[nt][reg]); } }
        __syncthreads();
    }
}

DI void p3_scan(const Args& a, int tid) {
    unsigned char* ws = a.ws;
    bf16* STS = (bf16*)(ws + WS_R1); bf16* STR = (bf16*)(ws + WS_R1 + STS_BYTES); const float* CD = (const float*)(ws + WS_CD);
    const int nth = gridDim.x * NTHR;
    for (int it = blockIdx.x * NTHR + tid; it < 98304; it += nth) {
        bf16* base; size_t stride; const float* cdp = nullptr; float cdec = 0.f;
        if (it < 65536) { const int b = it >> 14, h = (it >> 10) & 15, v = it & 1023; base = STS + ((size_t)(b * 64) * 16 + h) * 8192 + v * 8; stride = (size_t)16 * 8192; cdp = CD + (b * 64) * 16 + h; }
        else { const int j = it - 65536, b = j >> 13, h = (j >> 10) & 7, v = j & 1023; base = STR + ((size_t)(b * 64) * 8 + h) * 8192 + v * 8; stride = (size_t)8 * 8192; cdec = __expf(ret_lg(h) * 128.f); }
        float run[8];
#pragma unroll
        for (int e = 0; e < 8; ++e) run[e] = 0.f;
#pragma unroll 1
        for (int c0 = 0; c0 < 64; c0 += 8) {
            u32x4 s[8]; float dec[8];
#pragma unroll
            for (int k = 0; k < 8; ++k) { s[k] = *(const u32x4*)(base + (size_t)(c0 + k) * stride); dec[k] = cdp ? cdp[(c0 + k) * 16] : cdec; }
#pragma unroll
            for (int k = 0; k < 8; ++k) { float f[8]; unpack8(s[k], f); *(u32x4*)(base + (size_t)(c0 + k) * stride) = pack8(run);
#pragma unroll
                for (int e = 0; e < 8; ++e) run[e] = run[e] * dec[k] + f[e]; }
        }
    }
}

DI void p4_ssd_chunk(const Args& a, LAS unsigned char* lds, int bc, int tid, int wave, int lane) {
    unsigned char* ws = a.ws;
    const bf16* PROJ = (const bf16*)(ws + WS_BIG); const float* DT = (const float*)(ws + WS_DT);
    const bf16* STS = (const bf16*)(ws + WS_R1); const bf16* STR = (const bf16*)(ws + WS_R1 + STS_BYTES);
    bf16* YM = (bf16*)a.out;
    LAS float* dtl = (LAS float*)lds; LAS float* acs = (LAS float*)(lds + 8192);
    LAS float* ssq = (LAS float*)(lds + 16384);
    LAS float* ssr = (LAS float*)(lds + 16384 + 512);
    constexpr int BASE = 20992;
    LAS bf16* Cg = (LAS bf16*)(lds + BASE);
    LAS bf16* Gm = (LAS bf16*)(lds + BASE + 34816);
    LAS bf16* XT = (LAS bf16*)(lds + BASE + 69632);
    LAS bf16* PV = (LAS bf16*)(lds + BASE + 94208);
    LAS bf16* Yt = (LAS bf16*)(lds + BASE + 111616);
    LAS bf16* Qm = (LAS bf16*)(lds + BASE);
    LAS bf16* Km = (LAS bf16*)(lds + BASE + 18432);
    LAS bf16* Pm = (LAS bf16*)(lds + BASE + 36864);
    LAS bf16* Vm = (LAS bf16*)(lds + BASE + 71680);
    LAS bf16* PT = (LAS bf16*)(lds + BASE + 112640);
    const int t0 = bc * 128, pos0 = (bc & 63) * 128, hl = lane >> 5, mt = wave >> 1, wn = wave & 1;
    __syncthreads();
    chunk_prep(a, DT, bc, dtl, acs, wave, lane);
    for (int i = tid; i < 128; i += NTHR) ssq[i] = 0.f;
    const float* cw = a.in[3]; const float* cb = a.in[4];
#ifndef P4_SSD
#define P4_SSD 2
#endif
#ifndef P4_RET
#define P4_RET 8
#endif
    for (int g = 0; g < P4_SSD; ++g) {
        __syncthreads();
#pragma unroll 1
        for (int r = 0; r < 4; ++r) { const int it = tid + NTHR * r, l = it >> 4, c8 = (it & 15) * 8; float o[8];
            ssd_conv8(PROJ, cw, cb, t0 + l, pos0 + l, PC_C + g * 128 + c8, 1280 + g * 128 + c8, o);
            *(LAS u32x4*)(Cg + l * 136 + c8) = pack8(o);
            ssd_conv8(PROJ, cw, cb, t0 + l, pos0 + l, PC_B + g * 128 + c8, 1024 + g * 128 + c8, o);
            *(LAS u32x4*)(Gm + l * 136 + c8) = pack8(o); }
        __syncthreads();
        f32x16 cbm[2]; zero16(cbm[0]); zero16(cbm[1]);
        mma_tile<2, false, false>(cbm, Cg, 136, mt * 32, Gm, 136, wn * 64, 128, lane);
        __syncthreads();
        for (int hi = 0; hi < 8; ++hi) {
            const int h = g * 8 + hi;
#pragma unroll 1
            for (int r = 0; r < 2; ++r) { const int it = tid + NTHR * r, l = it >> 3, c8 = (it & 7) * 8, xc = h * 64 + c8; float o[8];
                ssd_conv8(PROJ, cw, cb, t0 + l, pos0 + l, PC_X + xc, xc, o);
                *(LAS u32x4*)(XT + l * 96 + c8) = pack8(o); }
#pragma unroll 1
            for (int r = 0; r < 2; ++r) { const int it = tid + NTHR * r, p = it >> 4, c8 = (it & 15) * 8;
                *(LAS u32x4*)(PV + p * 136 + c8) = *(const u32x4*)(STS + (size_t)(bc * 16 + h) * 8192 + p * 128 + c8); }
#pragma unroll
            for (int nt = 0; nt < 2; ++nt) { const int s = wn * 64 + nt * 32 + (lane & 31); const float as = acs[h * 128 + s], ds = dtl[h * 128 + s];
#pragma unroll
                for (int reg = 0; reg < 16; ++reg) { const int l = mt * 32 + crow(reg, hl);
                    const float v = (l >= s) ? cbm[nt][reg] * __expf(acs[h * 128 + l] - as) * ds : 0.f;
                    Gm[l * 136 + s] = f2bf(v); } }
            __syncthreads();
            f32x16 y1[1]; zero16(y1[0]);
            mma_tile<1, false, false>(y1, Cg, 136, mt * 32, PV, 136, wn * 32, 128, lane);
#pragma unroll
            for (int reg = 0; reg < 16; ++reg) y1[0][reg] *= __expf(acs[h * 128 + mt * 32 + crow(reg, hl)]);
            mma_tile<1, false, true>(y1, Gm, 136, mt * 32, XT, 96, wn * 32, 128, lane);
            { const float dsk = a.in[7][h]; const int p = wn * 32 + (lane & 31);
#pragma unroll
              for (int reg = 0; reg < 16; ++reg) { const int l = mt * 32 + crow(reg, hl);
                  const float y = y1[0][reg] + dsk * bf2f(XT[l * 96 + p]);
                  Yt[l * 72 + p] = f2bf(y); } }
            __syncthreads();
#pragma unroll 1
            for (int r = 0; r < 2; ++r) { const int it = tid + NTHR * r, l = it >> 3, c8 = (it & 7) * 8; float y[8], z[8];
                unpack8(*(const LAS u32x4*)(Yt + l * 72 + c8), y); unpack8(*(const u32x4*)(PROJ + (size_t)(t0 + l) * LDP + PC_Z + h * 64 + c8), z);
                float q = 0.f;
#pragma unroll
                for (int e = 0; e < 8; ++e) { y[e] *= silu(z[e]); q += y[e] * y[e]; }
                q += __shfl_xor(q, 1); q += __shfl_xor(q, 2); q += __shfl_xor(q, 4);
                if ((lane & 7) == 0) atomicAdd((float*)(ssq + l), q);
                *(u32x4*)(YM + (size_t)(t0 + l) * 2048 + h * 64 + c8) = pack8(y); }
        }
    }
    __syncthreads();
    { const float* nw = a.in[8];
#pragma unroll 1
      for (int r = 0; r < 32; ++r) { const int it = tid + NTHR * r, l = it >> 7, c8 = (it & 127) * 8;
          const float rstd = rsqrtf(ssq[l] * (1.f / 1024.f) + EPS);
          bf16* yp = YM + (size_t)(t0 + l) * 2048 + c8; float f[8]; unpack8(*(const u32x4*)yp, f);
          const f32x4 w0 = *(const f32x4*)(nw + c8), w1 = *(const f32x4*)(nw + c8 + 4);
          f[0] *= rstd * w0.x; f[1] *= rstd * w0.y; f[2] *= rstd * w0.z; f[3] *= rstd * w0.w; f[4] *= rstd * w1.x; f[5] *= rstd * w1.y; f[6] *= rstd * w1.z; f[7] *= rstd * w1.w;
          *(u32x4*)yp = pack8(f); } }
}

DI void p4_ret_chunk(const Args& a, LAS unsigned char* lds, int bc, int tid, int wave, int lane) {
    unsigned char* ws = a.ws;
    const bf16* PROJ = (const bf16*)(ws + WS_BIG);
    const bf16* STR = (const bf16*)(ws + WS_R1 + STS_BYTES);
    bf16* YM = (bf16*)a.out;
    LAS float* ssr = (LAS float*)(lds + 16384 + 512);
    constexpr int BASE = 20992;
    LAS bf16* Qm = (LAS bf16*)(lds + BASE);
    LAS bf16* Km = (LAS bf16*)(lds + BASE + 18432);
    LAS bf16* Pm = (LAS bf16*)(lds + BASE + 36864);
    LAS bf16* Vm = (LAS bf16*)(lds + BASE + 71680);
    LAS bf16* PT = (LAS bf16*)(lds + BASE + 112640);
    const int t0 = bc * 128, pos0 = (bc & 63) * 128, hl = lane >> 5, mt = wave >> 1, wn = wave & 1;
    __syncthreads();
    for (int i = tid; i < 1024; i += NTHR) ssr[i] = 0.f;
    for (int h = 0; h < P4_RET; ++h) {
        const float lg = ret_lg(h);
        __syncthreads();
        { const int l = tid >> 2, dg = (tid & 3) * 8;
          const bf16* qp = PROJ + (size_t)(t0 + l) * LDP + PC_Q + h * 64 + dg; const bf16* kp = PROJ + (size_t)(t0 + l) * LDP + PC_K + h * 64 + dg;
          u32x4 o1, o2;
          rotary8(*(const u32x4*)qp, *(const u32x4*)(qp + 32), pos0 + l, dg, 1.f, o1, o2);
          *(LAS u32x4*)(Qm + l * 72 + dg) = o1; *(LAS u32x4*)(Qm + l * 72 + 32 + dg) = o2;
          rotary8(*(const u32x4*)kp, *(const u32x4*)(kp + 32), pos0 + l, dg, 0.125f, o1, o2);
          *(LAS u32x4*)(Km + l * 72 + dg) = o1; *(LAS u32x4*)(Km + l * 72 + 32 + dg) = o2; }
#pragma unroll 1
        for (int r = 0; r < 4; ++r) { const int it = tid + NTHR * r, l = it >> 4, c8 = (it & 15) * 8;
            *(LAS u32x4*)(Vm + l * 160 + c8) = *(const u32x4*)(PROJ + (size_t)(t0 + l) * LDP + PC_V + h * 128 + c8); }
#pragma unroll 1
        for (int r = 0; r < 2; ++r) { const int it = tid + NTHR * r, e = it >> 3, c8 = (it & 7) * 8;
            *(LAS u32x4*)(PT + e * 72 + c8) = *(const u32x4*)(STR + (size_t)(bc * 8 + h) * 8192 + e * 64 + c8); }
        __syncthreads();
        { f32x16 sc[2]; zero16(sc[0]); zero16(sc[1]);
          mma_tile<2, false, false>(sc, Qm, 72, mt * 32, Km, 72, wn * 64, 64, lane);
#pragma unroll
          for (int nt = 0; nt < 2; ++nt) { const int s = wn * 64 + nt * 32 + (lane & 31);
#pragma unroll
              for (int reg = 0; reg < 16; ++reg) { const int l = mt * 32 + crow(reg, hl);
                  const float v = (l >= s) ? sc[nt][reg] * __expf(lg * (float)(l - s)) : 0.f;
                  Pm[l * 136 + s] = f2bf(v); } } }
        __syncthreads();
        f32x16 oi[2]; zero16(oi[0]); zero16(oi[1]);
        mma_tile<2, false, false>(oi, Qm, 72, mt * 32, PT, 72, wn * 64, 64, lane);
#pragma unroll
        for (int reg = 0; reg < 16; ++reg) { const float qd = __expf(lg * (float)(mt * 32 + crow(reg, hl) + 1)); oi[0][reg] *= qd; oi[1][reg] *= qd; }
        mma_tile<2, false, true>(oi, Pm, 136, mt * 32, Vm, 160, wn * 64, 128, lane);
#pragma unroll
        for (int reg = 0; reg < 16; ++reg) { const int l = mt * 32 + crow(reg, hl);
            const float q = half_sum32(oi[0][reg] * oi[0][reg] + oi[1][reg] * oi[1][reg]);
            if ((lane & 31) == 0) atomicAdd((float*)(ssr + h * 128 + l), q); }
        __syncthreads();
        { const float* rw = a.in[9];
#pragma unroll
          for (int nt = 0; nt < 2; ++nt) { const int e = wn * 64 + nt * 32 + (lane & 31); const float wv = rw[h * 128 + e];
#pragma unroll
              for (int reg = 0; reg < 16; ++reg) { const int l = mt * 32 + crow(reg, hl);
                  const float rstd = rsqrtf(ssr[h * 128 + l] * (1.f / 128.f) + EPS);
                  Pm[l * 136 + e] = f2bf(oi[nt][reg] * rstd * wv); } } }
        __syncthreads();
#pragma unroll 1
        for (int r = 0; r < 4; ++r) { const int it = tid + NTHR * r, l = it >> 4, c8 = (it & 15) * 8; float o[8], gv[8];
            unpack8(*(const LAS u32x4*)(Pm + l * 136 + c8), o); unpack8(*(const u32x4*)(PROJ + (size_t)(t0 + l) * LDP + PC_G + h * 128 + c8), gv);
#pragma unroll
            for (int e = 0; e < 8; ++e) o[e] *= silu(gv[e]);
            *(u32x4*)(YM + (size_t)(t0 + l) * 2048 + 1024 + h * 128 + c8) = pack8(o); }
    }
}

DI void p6_norm(const Args& a, int wave, int lane) {
    unsigned char* ws = a.ws;
    const float* Y = (const float*)(ws + WS_BIG); bf16* H = (bf16*)(ws + WS_R1);
    const int gw = blockIdx.x * 8 + wave, NGW = gridDim.x * 8;
    const f32x4* w1p = (const f32x4*)a.in[11]; const f32x4* w2p = (const f32x4*)a.in[12];
    f32x4 w1[4], w2[4];
#pragma unroll
    for (int j = 0; j < 4; ++j) { w1[j] = w1p[lane + 64 * j]; w2[j] = w2p[lane + 64 * j]; }
    for (int m = gw; m < T_TOK; m += NGW) {
        const f32x4* yr = (const f32x4*)(Y + (size_t)m * DM) + lane; const f32x4* xr = (const f32x4*)(a.in[0] + (size_t)m * DM) + lane;
        f32x4 y[4], x[4]; float s = 0.f;
#pragma unroll
        for (int j = 0; j < 4; ++j) { y[j] = yr[64 * j]; x[j] = xr[64 * j]; s += (y[j].x * y[j].x + y[j].y * y[j].y) + (y[j].z * y[j].z + y[j].w * y[j].w); }
        const float rstd = rsqrtf(wave_sum(s) * (1.f / DM) + EPS); float s2 = 0.f;
        f32x4* orow = (f32x4*)(a.out + (size_t)m * DM) + lane;
#pragma unroll
        for (int j = 0; j < 4; ++j) { x[j] = x[j] + y[j] * rstd * w1[j]; orow[64 * j] = x[j]; s2 += (x[j].x * x[j].x + x[j].y * x[j].y) + (x[j].z * x[j].z + x[j].w * x[j].w); }
        const float rstd2 = rsqrtf(wave_sum(s2) * (1.f / DM) + EPS);
        u32x2* o = (u32x2*)(H + (size_t)m * DM) + lane;
#pragma unroll
        for (int j = 0; j < 4; ++j) { u32x2 w; w.x = cvtpk(x[j].x * rstd2 * w2[j].x, x[j].y * rstd2 * w2[j].y); w.y = cvtpk(x[j].z * rstd2 * w2[j].z, x[j].w * rstd2 * w2[j].w); o[64 * j] = w; }
    }
}

DI void p8_act(const Args& a, int tid) {
    bf16* UP = (bf16*)(a.ws + WS_BIG); const float* cw = a.in[14]; const float* cb = a.in[15];
    for (int bc = blockIdx.x; bc < NCHUNK; bc += gridDim.x) {
#pragma unroll 1
        for (int r = 0; r < 6; ++r) { const int it = tid + NTHR * r; if (it >= 2816) break;
            const int cgi = it % 352, sub = it / 352, c0 = cgi * 8, t = bc * 128 + sub * 16, pos = (bc & 63) * 128 + sub * 16;
            float w[3][8], b[8];
#pragma unroll
            for (int j = 0; j < 3; ++j) { const f32x4 u0 = *(const f32x4*)(cw + j * DFF + c0), u1 = *(const f32x4*)(cw + j * DFF + c0 + 4);
                w[j][0] = u0.x; w[j][1] = u0.y; w[j][2] = u0.z; w[j][3] = u0.w; w[j][4] = u1.x; w[j][5] = u1.y; w[j][6] = u1.z; w[j][7] = u1.w; }
            { const f32x4 u0 = *(const f32x4*)(cb + c0), u1 = *(const f32x4*)(cb + c0 + 4); b[0] = u0.x; b[1] = u0.y; b[2] = u0.z; b[3] = u0.w; b[4] = u1.x; b[5] = u1.y; b[6] = u1.z; b[7] = u1.w; }
            float g2[8], g1[8];
            if (pos >= 2) { unpack8(*(const u32x4*)(UP + (size_t)(t - 2) * LDU + c0), g2); unpack8(*(const u32x4*)(UP + (size_t)(t - 1) * LDU + c0), g1); }
            else {
#pragma unroll
                for (int e = 0; e < 8; ++e) { g2[e] = 0.f; g1[e] = 0.f; } }
#pragma unroll 4
            for (int k = 0; k < 16; ++k) { bf16* rowp = UP + (size_t)(t + k) * LDU + c0;
                float g0[8], v[8], o[8]; unpack8(*(const u32x4*)rowp, g0); unpack8(*(const u32x4*)(rowp + DFF), v);
#pragma unroll
                for (int e = 0; e < 8; ++e) { const float s = b[e] + w[0][e] * g2[e] + w[1][e] * g1[e] + w[2][e] * g0[e]; o[e] = silu(s) * v[e]; g2[e] = g1[e]; g1[e] = g0[e]; }
                *(u32x4*)(rowp + DFF) = pack8(o); }
        }
    }
}

DI void p10_final(const Args& a, int wave, int lane) {
    const bf16* F = (const bf16*)(a.ws + WS_R1);
    const int gw = blockIdx.x * 8 + wave, NGW = gridDim.x * 8;
    const float* wp = a.in[17];
    for (int m = gw; m < T_TOK; m += NGW) {
        float f[2][8]; float s = 0.f;
#pragma unroll
        for (int j = 0; j < 2; ++j) { unpack8(*(const u32x4*)(F + (size_t)m * DM + (lane + 64 * j) * 8), f[j]);
#pragma unroll
            for (int e = 0; e < 8; ++e) s += f[j][e] * f[j][e]; }
        const float rstd = rsqrtf(wave_sum(s) * (1.f / DM) + EPS);
#pragma unroll
        for (int j = 0; j < 2; ++j) { float* op = a.out + (size_t)m * DM + (lane + 64 * j) * 8; const float* wq = wp + (lane + 64 * j) * 8;
            f32x4 x0 = *(const f32x4*)op, x1 = *(const f32x4*)(op + 4); const f32x4 w0 = *(const f32x4*)wq, w1 = *(const f32x4*)(wq + 4);
            x0.x += f[j][0] * rstd * w0.x; x0.y += f[j][1] * rstd * w0.y; x0.z += f[j][2] * rstd * w0.z; x0.w += f[j][3] * rstd * w0.w;
            x1.x += f[j][4] * rstd * w1.x; x1.y += f[j][5] * rstd * w1.y; x1.z += f[j][6] * rstd * w1.z; x1.w += f[j][7] * rstd * w1.w;
            *(f32x4*)op = x0; *(f32x4*)(op + 4) = x1; }
    }
}

constexpr int N_PHASES = 11;
__global__ void __launch_bounds__(NTHR, 2) hymba_fwd(Args args) {
    extern __shared__ __attribute__((aligned(16))) unsigned char lds_raw[];
    LAS unsigned char* lds = (LAS unsigned char*)lds_raw;
    const int tid = threadIdx.x, lane = tid & 63, wave = __builtin_amdgcn_readfirstlane(tid >> 6);
    unsigned char* ws = args.ws;
    const int lo = args.ph_lo, hi = args.ph_hi;
#ifndef PHMASK
#define PHMASK 0x7ff
#endif
#define IN(k) (((PHMASK >> (k)) & 1) && lo <= (k) && (k) < hi)
#define SEAM(k) do { if (IN(k) && IN((k) + 1)) { cgrp::this_grid().sync(); } } while (0)
    if (IN(0)) { p0_prologue(args, lds, wave, lane); }
    SEAM(0);
    if (IN(1)) {
        pg8::Gemm g{(const bf16*)(ws + WS_R1), (const bf16*)(ws + WS_WIN), T_TOK, NINP, 1024, 1024}; pg8::StaticOrder S; S.init(T_TOK, NINP, gridDim.x, (int)blockIdx.x);
        pg8::EpiProj E{(bf16*)(ws + WS_BIG), (float*)(ws + WS_DT)};
        pg8::gemm_phase<pg8::EpiProj, pg8::StaticOrder, true, true>(lds, g, S, E);
    }
    SEAM(1);
    if (IN(2)) { for (int bc = blockIdx.x; bc < NCHUNK; bc += gridDim.x) p2_chunk(args, lds, bc, tid, wave, lane); }
    SEAM(2);
    if (IN(3)) { p3_scan(args, tid); }
    SEAM(3);
    if (IN(4)) { for (int bc = blockIdx.x; bc < NCHUNK; bc += gridDim.x) p4_ssd_chunk(args, lds, bc, tid, wave, lane);
                 for (int bc = blockIdx.x; bc < NCHUNK; bc += gridDim.x) p4_ret_chunk(args, lds, bc, tid, wave, lane); }
    SEAM(4);
    if (IN(5)) {
        __syncthreads();
        pg8::Gemm g{(const bf16*)args.out, (const bf16*)(ws + WS_WOUT), T_TOK, 1024, 2048, 2048}; pg8::StaticOrder S; S.init(T_TOK, 1024, gridDim.x, (int)blockIdx.x);
        pg8::EpiF32 E{(float*)(ws + WS_BIG), 1024};
        pg8::gemm_phase<pg8::EpiF32, pg8::StaticOrder, true, true>(lds, g, S, E);
    }
    SEAM(5);
    if (IN(6)) { p6_norm(args, wave, lane); }
    SEAM(6);
    if (IN(7)) {
        pg8::Gemm g{(const bf16*)(ws + WS_R1), (const bf16*)(ws + WS_WUP), T_TOK, 5632, 1024, 1024}; pg8::StaticOrder S; S.init(T_TOK, 5632, gridDim.x, (int)blockIdx.x);
        pg8::EpiBf16 E{(bf16*)(ws + WS_BIG), LDU};
        pg8::gemm_phase<pg8::EpiBf16, pg8::StaticOrder, true, true>(lds, g, S, E);
    }
    SEAM(7);
    if (IN(8)) { p8_act(args, tid); }
    SEAM(8);
    if (IN(9)) {
        pg8::Gemm g{(const bf16*)(ws + WS_BIG) + DFF, (const bf16*)(ws + WS_WDN), T_TOK, 1024, 2816, LDU}; pg8::StaticOrder S; S.init(T_TOK, 1024, gridDim.x, (int)blockIdx.x);
        pg8::EpiBf16 E{(bf16*)(ws + WS_R1), 1024};
        pg8::gemm_phase<pg8::EpiBf16, pg8::StaticOrder, true, true>(lds, g, S, E);
    }
    SEAM(9);
    if (IN(10)) { p10_final(args, wave, lane); }
#undef IN
#undef SEAM
}

#ifndef MK_ONE_LAUNCH
#define MK_ONE_LAUNCH 1
#endif
extern "C" void kernel_launch(void* const* d_in, const int* in_sizes, int n_in, void* d_out, int out_size, void* d_ws, size_t ws_size, hipStream_t stream) {
    static int grid = 0;
    if (grid == 0) {
        if (n_in != 18 || out_size != T_TOK * DM || ws_size < WS_END) { fprintf(stderr, "kernel_launch: unexpected shapes: n_in %d out %d ws %zu (need %zu)\n", n_in, out_size, ws_size, (size_t)WS_END); grid = -1; return; }
        int dev = 0, cus = 0, per_cu = 0;
        hipGetDevice(&dev); hipDeviceGetAttribute(&cus, hipDeviceAttributeMultiprocessorCount, dev);
        if (hipFuncSetAttribute((const void*)hymba_fwd, hipFuncAttributeMaxDynamicSharedMemorySize, LDS_BYTES) != hipSuccess) { fprintf(stderr, "kernel_launch: hipFuncSetAttribute failed\n"); grid = -1; return; }
        hipOccupancyMaxActiveBlocksPerMultiprocessor(&per_cu, (const void*)hymba_fwd, NTHR, LDS_BYTES);
        if (per_cu < 1) { fprintf(stderr, "kernel_launch: occupancy query says %d blocks per CU\n", per_cu); per_cu = 1; }
        (void)hipGetLastError();
        grid = cus;
    }
    if (grid < 0) return;
    Args a{};
    for (int i = 0; i < 18; ++i) a.in[i] = (const float*)d_in[i];
    a.out = (float*)d_out; a.ws = (unsigned char*)d_ws;
#if MK_ONE_LAUNCH
    a.ph_lo = 0; a.ph_hi = N_PHASES;
    void* kargs[] = {&a};
    hipError_t e = hipLaunchCooperativeKernel((const void*)hymba_fwd, dim3(grid), dim3(NTHR), kargs, LDS_BYTES, stream);
    if (e != hipSuccess) fprintf(stderr, "cooperative launch failed: %s (grid %d)\n", hipGetErrorString(e), grid);
#else
    for (int p = 0; p < N_PHASES; ++p) {
        a.ph_lo = p; a.ph_hi = p + 1;
        hipLaunchKernelGGL(hymba_fwd, dim3(grid), dim3(NTHR), LDS_BYTES, stream, a);
    }
#endif
}
```

```cpp
#include <hip/hip_runtime.h>
#include <hip/hip_cooperative_groups.h>
#include <cstdio>
#include <cstdint>
namespace cgrp = cooperative_groups;

namespace pg8 {
#define PG8_LAS __attribute__((address_space(3)))
typedef unsigned short bf16_t;
typedef short bf16x8 __attribute__((ext_vector_type(8)));
typedef float f32x4 __attribute__((ext_vector_type(4)));
typedef unsigned u32x4 __attribute__((ext_vector_type(4)));
constexpr int BM = 256, BK = 64, HALF = 128, HTB = HALF * BK * 2  , STAGE_BYTES = 8 * HTB, NXCD = 8, WGM = 8;

__host__ __device__ __forceinline__ int lds_byte(int r, int c) { const int st = (r >> 4) * 2 + (c >> 5), rr = r & 15, cc = c & 31, ob = rr * 64 + cc * 2; return st * 1024 + (ob ^ (((ob >> 9) & 1) << 5)); }
__host__ __device__ __forceinline__ void stage_rc(int b, int& R, int& C) { const int st = b / 1024, sb = b % 1024, swz = sb ^ (((sb >> 9) & 1) << 5); R = (st >> 1) * 16 + swz / 64; C = (st & 1) * 32 + (swz % 64) / 2; }
__host__ __device__ __forceinline__ int perm32(int rho) { const int n = rho >> 4, i = rho & 15; return 8 * (i >> 2) + 4 * n + (i & 3); }

struct Unit { int pm, pn; };
struct Gemm { const bf16_t* A; const bf16_t* Bt; int M, N, K, lda; };

struct StaticOrder {
    int nM, nN, nwg, G, c;
    __host__ __device__ void init(int M, int N, int G_, int c_) { nM = M / BM; nN = N / BM; nwg = nM * nN; G = G_; c = c_; }
    __host__ __device__ bool next(int i, Unit& u) const {
        const long L = (long)i * G + c; if (L >= nwg) return false;
        int wgid = (int)L; { const int q = nwg / NXCD, r = nwg % NXCD, xcd = wgid % NXCD, off = wgid / NXCD; wgid = (xcd < r ? xcd * (q + 1) : r * (q + 1) + (xcd - r) * q) + off; }
        const int nig = WGM * nN, gid = wgid / nig, fm = gid * WGM, gsz = (nM - fm) < WGM ? (nM - fm) : WGM;
        u.pm = fm + ((wgid % nig) % gsz); u.pn = (wgid % nig) / gsz; return true;
    }
    __device__ __forceinline__ void a_ready(const Unit&) const {}
    __device__ __forceinline__ void done(const Unit&) const {}
};

__device__ __forceinline__ unsigned cvt_pk_bf16(float lo, float hi) { unsigned r; asm volatile("v_cvt_pk_bf16_f32 %0, %1, %2" : "=v"(r) : "v"(lo), "v"(hi)); return r; }
struct EpiBf16 {
    static constexpr bool PERM = true, AFTER_DRAIN = false;
    bf16_t* O; int ldc;
    __device__ __forceinline__ void operator()(const f32x4 (&acc)[2][2][4][2], const Unit& u, int wr, int wc, int fr, int fq) const {
        const int row0 = u.pm * BM + wr * 64 + fr, col0 = u.pn * BM + wc * 32 + 8 * fq;
#pragma unroll
        for (int ai = 0; ai < 2; ++ai)
#pragma unroll
            for (int m = 0; m < 4; ++m) { bf16_t* rowp = O + (size_t)(row0 + ai * HALF + m * 16) * ldc + col0;
#pragma unroll
                for (int bj = 0; bj < 2; ++bj) { const f32x4 v0 = acc[ai][bj][m][0], v1 = acc[ai][bj][m][1];
                    u32x4 w; w.x = cvt_pk_bf16(v0[0], v0[1]); w.y = cvt_pk_bf16(v0[2], v0[3]); w.z = cvt_pk_bf16(v1[0], v1[1]); w.w = cvt_pk_bf16(v1[2], v1[3]);
                    *(u32x4*)(rowp + bj * HALF) = w; } }
    }
};
struct EpiProj {
    static constexpr bool PERM = true, AFTER_DRAIN = false;
    bf16_t* O; float* DT;
    __device__ __forceinline__ void operator()(const f32x4 (&acc)[2][2][4][2], const Unit& u, int wr, int wc, int fr, int fq) const {
        const int row0 = u.pm * BM + wr * 64 + fr;
        if (u.pn < 22) {
            const int col0 = u.pn * BM + wc * 32 + 8 * fq;
#pragma unroll
            for (int ai = 0; ai < 2; ++ai)
#pragma unroll
                for (int m = 0; m < 4; ++m) { bf16_t* rowp = O + (size_t)(row0 + ai * HALF + m * 16) * 5632 + col0;
#pragma unroll
                    for (int bj = 0; bj < 2; ++bj) { const f32x4 v0 = acc[ai][bj][m][0], v1 = acc[ai][bj][m][1];
                        u32x4 w; w.x = cvt_pk_bf16(v0[0], v0[1]); w.y = cvt_pk_bf16(v0[2], v0[3]); w.z = cvt_pk_bf16(v1[0], v1[1]); w.w = cvt_pk_bf16(v1[2], v1[3]);
                        *(u32x4*)(rowp + bj * HALF) = w; } }
        } else if (wc == 0 && fq < 2) {
#pragma unroll
            for (int ai = 0; ai < 2; ++ai)
#pragma unroll
                for (int m = 0; m < 4; ++m) { float* p = DT + (size_t)(row0 + ai * HALF + m * 16) * 16 + 8 * fq;
                    *(f32x4*)p = acc[ai][0][m][0]; *(f32x4*)(p + 4) = acc[ai][0][m][1]; }
        }
    }
};
struct EpiF32 {
    static constexpr bool PERM = true, AFTER_DRAIN = false;
    float* O; int ldc;
    __device__ __forceinline__ void operator()(const f32x4 (&acc)[2][2][4][2], const Unit& u, int wr, int wc, int fr, int fq) const {
        const int row0 = u.pm * BM + wr * 64 + fr, col0 = u.pn * BM + wc * 32 + 8 * fq;
#pragma unroll
        for (int ai = 0; ai < 2; ++ai)
#pragma unroll
            for (int m = 0; m < 4; ++m) { float* rowp = O + (size_t)(row0 + ai * HALF + m * 16) * ldc + col0;
#pragma unroll
                for (int bj = 0; bj < 2; ++bj) { *(f32x4*)(rowp + bj * HALF) = acc[ai][bj][m][0]; *(f32x4*)(rowp + bj * HALF + 4) = acc[ai][bj][m][1]; } }
    }
};
template <class Epi, class Sched, bool ALIGN_EPI = false, bool SP2 = false>
__device__ __forceinline__ void gemm_phase(PG8_LAS unsigned char* lds, const Gemm g, const Sched& S, const Epi& E) {
    const int tid = threadIdx.x, wid = __builtin_amdgcn_readfirstlane(tid >> 6), lane = tid & 63, wr = wid >> 2, wc = wid & 3, fr = lane & 15, fq = lane >> 4;
    const int K = g.K, nt = K / BK;
    unsigned voffA[2], voffB[2];
#pragma unroll
    for (int i = 0; i < 2; ++i) { int R, C; stage_rc(tid * 16 + i * 8192, R, C); const int Rb = Epi::PERM ? ((R & ~31) + perm32(R & 31)) : R;
        voffA[i] = (unsigned)(R * g.lda + C) * 2u; voffB[i] = (unsigned)(Rb * K + C) * 2u; }
    const size_t kstep = (size_t)(BK * 2);
    const size_t hstepA = (size_t)HALF * g.lda * 2, hstepB = (size_t)HALF * K * 2;
    const size_t tstepA = 2 * hstepA, tstepB = 2 * hstepB;
    const unsigned ldsw = (unsigned)wid * 1024u;
    const int aoff = lds_byte(wr * 64 + fr, fq * 8), boff = lds_byte(wc * 32 + fr, fq * 8);
#define PG8_SA(b, h) (((b) * 2 + (h)) * HTB)
#define PG8_SB(b, h) ((4 + (b) * 2 + (h)) * HTB)
#define PG8_STAGE(bufoff, gbase, voff) do { _Pragma("unroll") for (int _i = 0; _i < 2; ++_i) \
        __builtin_amdgcn_global_load_lds((const unsigned*)((const char*)(gbase) + (voff)[_i]), (PG8_LAS unsigned*)(lds + (bufoff) + ldsw + _i * 8192), 16, 0, 0); } while (0)
#define PG8_LDA(dst, b, h) do { _Pragma("unroll") for (int m = 0; m < 4; ++m) _Pragma("unroll") for (int k = 0; k < 2; ++k) dst[m][k] = *(const PG8_LAS bf16x8*)(lds + PG8_SA(b, h) + aoff + m * 2048 + k * 1024); } while (0)
#define PG8_LDB(dst, b, h) do { _Pragma("unroll") for (int n = 0; n < 2; ++n) _Pragma("unroll") for (int k = 0; k < 2; ++k) dst[n][k] = *(const PG8_LAS bf16x8*)(lds + PG8_SB(b, h) + boff + n * 2048 + k * 1024); } while (0)
#define PG8_MMA(ai, bj, At, Bt) do { __builtin_amdgcn_s_setprio(1); _Pragma("unroll") for (int m = 0; m < 4; ++m) _Pragma("unroll") for (int n = 0; n < 2; ++n) _Pragma("unroll") for (int k = 0; k < 2; ++k) \
        acc[ai][bj][m][n] = __builtin_amdgcn_mfma_f32_16x16x32_bf16(Bt[n][k], At[m][k], acc[ai][bj][m][n], 0, 0, 0); __builtin_amdgcn_s_setprio(0); } while (0)
#define PG8_WAIT_V(n) asm volatile("s_waitcnt vmcnt(" #n ")" ::: "memory")
#define PG8_WAIT_L(n) asm volatile("s_waitcnt lgkmcnt(" #n ")" ::: "memory")
#define PG8_BAR __builtin_amdgcn_s_barrier()
#define PG8_SCHED __builtin_amdgcn_sched_barrier(0)
    Unit cur, nxt; int ui = 0;
    if (!S.next(0, cur)) return;
    f32x4 acc[2][2][4][2];
#pragma unroll
    for (int a = 0; a < 2; ++a)
#pragma unroll
        for (int b = 0; b < 2; ++b)
#pragma unroll
            for (int m = 0; m < 4; ++m)
#pragma unroll
                for (int n = 0; n < 2; ++n) acc[a][b][m][n] = (f32x4){0.f, 0.f, 0.f, 0.f};
    bf16x8 At[4][2], B0[2][2], B1[2][2];
    const char* cA = (const char*)g.A + (size_t)cur.pm * tstepA; const char* cB = (const char*)g.Bt + (size_t)cur.pn * tstepB;
    S.a_ready(cur);
    if constexpr (SP2) {
        PG8_STAGE(PG8_SB(0, 0), cB, voffB); PG8_STAGE(PG8_SB(0, 1), cB + hstepB, voffB); PG8_STAGE(PG8_SA(0, 0), cA, voffA); PG8_STAGE(PG8_SA(0, 1), cA + hstepA, voffA);
        if (wr == 1) PG8_BAR;
        PG8_WAIT_V(2); PG8_BAR;
        PG8_STAGE(PG8_SB(1, 0), cB + kstep, voffB); PG8_STAGE(PG8_SA(1, 0), cA + kstep, voffA); PG8_STAGE(PG8_SB(1, 1), cB + hstepB + kstep, voffB);
        PG8_WAIT_V(6); PG8_BAR;
    } else {
        PG8_STAGE(PG8_SB(0, 0), cB, voffB); PG8_STAGE(PG8_SA(0, 0), cA, voffA); PG8_STAGE(PG8_SB(0, 1), cB + hstepB, voffB); PG8_STAGE(PG8_SA(0, 1), cA + hstepA, voffA);
        if (wr == 1) PG8_BAR;
        PG8_WAIT_V(4); PG8_BAR;
        PG8_STAGE(PG8_SB(1, 0), cB + kstep, voffB); PG8_STAGE(PG8_SA(1, 0), cA + kstep, voffA); PG8_STAGE(PG8_SB(1, 1), cB + hstepB + kstep, voffB);
        PG8_WAIT_V(6); PG8_BAR;
    }
    for (;;) {
        const bool has_next = S.next(ui + 1, nxt);
        const char* nA = has_next ? (const char*)g.A + (size_t)nxt.pm * tstepA : cA; const char* nB = has_next ? (const char*)g.Bt + (size_t)nxt.pn * tstepB : cB;
        for (int t = 0; t < nt; t += 2) {
            const bool last = (t == nt - 2);
            const char* a1 = cA + (size_t)(t + 1) * kstep;
            const char* a2 = last ? nA : cA + (size_t)(t + 2) * kstep; const char* b2 = last ? nB : cB + (size_t)(t + 2) * kstep;
            const char* a3 = a2 + kstep; const char* b3 = b2 + kstep;
            if (last && has_next) S.a_ready(nxt);
            if constexpr (SP2) {
            PG8_LDB(B0, 0, 0); PG8_LDB(B1, 0, 1); PG8_SCHED; PG8_LDA(At, 0, 0); PG8_STAGE(PG8_SA(1, 1), a1 + hstepA, voffA);
            PG8_WAIT_V(8); PG8_WAIT_L(0); PG8_BAR; PG8_MMA(0, 0, At, B0); PG8_MMA(0, 1, At, B1); PG8_BAR; PG8_SCHED;
            PG8_LDA(At, 0, 1); PG8_STAGE(PG8_SB(0, 0), b2, voffB); PG8_STAGE(PG8_SB(0, 1), b2 + hstepB, voffB); PG8_STAGE(PG8_SA(0, 0), a2, voffA);
            PG8_WAIT_V(8); PG8_WAIT_L(0); PG8_BAR; PG8_MMA(1, 0, At, B0); PG8_MMA(1, 1, At, B1); PG8_BAR; PG8_SCHED;
            PG8_LDB(B0, 1, 0); PG8_LDB(B1, 1, 1); PG8_SCHED; PG8_LDA(At, 1, 0); PG8_STAGE(PG8_SA(0, 1), a2 + hstepA, voffA);
            PG8_WAIT_V(8); PG8_WAIT_L(0); PG8_BAR; PG8_MMA(0, 0, At, B0); PG8_MMA(0, 1, At, B1); PG8_BAR; PG8_SCHED;
            PG8_LDA(At, 1, 1); PG8_STAGE(PG8_SB(1, 0), b3, voffB); PG8_STAGE(PG8_SB(1, 1), b3 + hstepB, voffB); PG8_STAGE(PG8_SA(1, 0), a3, voffA);
            PG8_WAIT_V(8); PG8_WAIT_L(0); PG8_BAR; PG8_MMA(1, 0, At, B0); PG8_MMA(1, 1, At, B1); PG8_BAR; PG8_SCHED;
            } else {
            PG8_LDB(B0, 0, 0); PG8_SCHED; PG8_LDA(At, 0, 0); PG8_STAGE(PG8_SA(1, 1), a1 + hstepA, voffA);
            PG8_WAIT_L(8); PG8_BAR; PG8_WAIT_L(0); PG8_MMA(0, 0, At, B0); PG8_BAR; PG8_SCHED;
            PG8_LDB(B1, 0, 1); PG8_STAGE(PG8_SB(0, 0), b2, voffB);
            PG8_BAR; PG8_WAIT_L(0); PG8_MMA(0, 1, At, B1); PG8_BAR;
            PG8_LDA(At, 0, 1); PG8_STAGE(PG8_SA(0, 0), a2, voffA);
            PG8_BAR; PG8_WAIT_L(0); PG8_MMA(1, 0, At, B0); PG8_BAR; PG8_SCHED;
            PG8_STAGE(PG8_SB(0, 1), b2 + hstepB, voffB);
            PG8_WAIT_V(6); PG8_BAR; PG8_MMA(1, 1, At, B1); PG8_BAR;
            PG8_LDB(B0, 1, 0); PG8_SCHED; PG8_LDA(At, 1, 0); PG8_STAGE(PG8_SA(0, 1), a2 + hstepA, voffA);
            PG8_WAIT_L(8); PG8_BAR; PG8_WAIT_L(0); PG8_MMA(0, 0, At, B0); PG8_BAR; PG8_SCHED;
            PG8_LDB(B1, 1, 1); PG8_STAGE(PG8_SB(1, 0), b3, voffB);
            PG8_BAR; PG8_WAIT_L(0); PG8_MMA(0, 1, At, B1); PG8_BAR;
            PG8_LDA(At, 1, 1); PG8_STAGE(PG8_SA(1, 0), a3, voffA);
            PG8_BAR; PG8_WAIT_L(0); PG8_MMA(1, 0, At, B0); PG8_BAR; PG8_SCHED;
            PG8_STAGE(PG8_SB(1, 1), b3 + hstepB, voffB);
            PG8_WAIT_V(6); PG8_BAR; PG8_MMA(1, 1, At, B1); PG8_BAR;
            }
        }
        if constexpr (ALIGN_EPI) { if (wr == 0) PG8_BAR; }
        if constexpr (!Epi::AFTER_DRAIN) { E(acc, cur, wr, wc, fr, fq); S.done(cur); }
        if (!has_next) break;
#pragma unroll
        for (int a = 0; a < 2; ++a)
#pragma unroll
            for (int b = 0; b < 2; ++b)
#pragma unroll
                for (int m = 0; m < 4; ++m)
#pragma unroll
                    for (int n = 0; n < 2; ++n) acc[a][b][m][n] = (f32x4){0.f, 0.f, 0.f, 0.f};
        cur = nxt; cA = nA; cB = nB; ++ui;
        if constexpr (ALIGN_EPI) { if (wr == 1) PG8_BAR; }
    }
    PG8_WAIT_V(0);
    if constexpr (!ALIGN_EPI) { if (wr == 0) PG8_BAR; }
    PG8_BAR;
    if constexpr (Epi::AFTER_DRAIN) { E.fused(acc, cur, wr, wc, fr, fq, lds, wid, lane); S.done(cur); }
#undef PG8_SA
#undef PG8_SB
#undef PG8_STAGE
#undef PG8_LDA
#undef PG8_LDB
#undef PG8_MMA
#undef PG8_WAIT_V
#undef PG8_WAIT_L
#undef PG8_BAR
#undef PG8_SCHED
}
}

#define LAS __attribute__((address_space(3)))
#define DI __device__ __forceinline__
typedef unsigned short bf16;
typedef short bf16x8 __attribute__((ext_vector_type(8)));
typedef short s16x4 __attribute__((ext_vector_type(4)));
typedef float f32x4 __attribute__((ext_vector_type(4)));
typedef float f32x16 __attribute__((ext_vector_type(16)));
typedef unsigned u32x4 __attribute__((ext_vector_type(4)));
typedef unsigned u32x2 __attribute__((ext_vector_type(2)));

constexpr int T_TOK = 32768, DM = 1024, NCHUNK = 256;
constexpr int LDP = 5632;
constexpr int NINP = 5888;
constexpr int DFF = 2816, LDU = 5632;
constexpr int PC_Z = 0, PC_X = 1024, PC_B = 2048, PC_C = 2304, PC_Q = 2560, PC_K = 3072, PC_V = 3584, PC_G = 4608;
constexpr float EPS = 1e-6f;
constexpr size_t MiB = 1u << 20;
constexpr size_t WS_R1 = 1 * MiB;
constexpr size_t WS_BIG = 97 * MiB;
constexpr size_t WS_WIN = 449 * MiB;
constexpr size_t WS_WOUT = WS_WIN + (size_t)NINP * 1024 * 2;
constexpr size_t WS_WUP = WS_WOUT + (size_t)1024 * 2048 * 2;
constexpr size_t WS_WDN = WS_WUP + (size_t)5632 * 1024 * 2;
constexpr size_t WS_DT = 481 * MiB;
constexpr size_t WS_CD = 483 * MiB;
constexpr size_t WS_END = 484 * MiB;
static_assert(WS_WDN + (size_t)1024 * 2816 * 2 <= WS_DT, "ws map");
constexpr size_t STS_BYTES = (size_t)256 * 16 * 8192 * 2;
constexpr int LDS_BYTES = 155648;
constexpr int NTHR = 512;

struct Args { const float* in[18]; float* out; unsigned char* ws; int ph_lo, ph_hi; };

DI float bf2f(unsigned v) { return __uint_as_float(v << 16); }
DI unsigned cvtpk(float lo, float hi) { unsigned r; asm("v_cvt_pk_bf16_f32 %0, %1, %2" : "=v"(r) : "v"(lo), "v"(hi)); return r; }
DI bf16 f2bf(float f) { return (bf16)(cvtpk(f, 0.f) & 0xffffu); }
DI void unpack8(const u32x4 v, float (&f)[8]) {
    f[0] = __uint_as_float(v.x << 16); f[1] = __uint_as_float(v.x & 0xffff0000u); f[2] = __uint_as_float(v.y << 16); f[3] = __uint_as_float(v.y & 0xffff0000u);
    f[4] = __uint_as_float(v.z << 16); f[5] = __uint_as_float(v.z & 0xffff0000u); f[6] = __uint_as_float(v.w << 16); f[7] = __uint_as_float(v.w & 0xffff0000u);
}
DI u32x4 pack8(const float (&f)[8]) { u32x4 w; w.x = cvtpk(f[0], f[1]); w.y = cvtpk(f[2], f[3]); w.z = cvtpk(f[4], f[5]); w.w = cvtpk(f[6], f[7]); return w; }
DI float silu(float x) { return x / (1.f + __expf(-x)); }
DI float softplus(float x) { return fmaxf(x, 0.f) + log1pf(__expf(-fabsf(x))); }
DI float wave_sum(float v) {
#pragma unroll
    for (int o = 1; o < 64; o <<= 1) v += __shfl_xor(v, o);
    return v;
}
DI float half_sum32(float v) {
#pragma unroll
    for (int o = 1; o < 32; o <<= 1) v += __shfl_xor(v, o);
    return v;
}
DI int crow(int reg, int h) { return (reg & 3) + 8 * (reg >> 2) + 4 * h; }
DI float ret_lg(int h) { return log1pf(-exp2f(-5.f - (float)h)); }

typedef short v4i16_t __attribute__((ext_vector_type(4)));
DI bf16x8 frag_row(const LAS bf16* T, int ld, int row0, int k0, int lane) {
    return *(const LAS bf16x8*)(T + (row0 + (lane & 31)) * ld + k0 + 8 * (lane >> 5));
}
DI bf16x8 frag_tr(const LAS bf16* T, int ld, int row0, int k0, int lane) {
    const int h = lane >> 5, blk = (lane >> 4) & 1, q = (lane & 15) >> 2, p = lane & 3;
    const LAS bf16* a = T + (k0 + 8 * h + q) * ld + row0 + 16 * blk + 4 * p;
    const v4i16_t lo = __builtin_amdgcn_ds_read_tr16_b64_v4i16((LAS v4i16_t*)a);
    const v4i16_t hi = __builtin_amdgcn_ds_read_tr16_b64_v4i16((LAS v4i16_t*)(a + 4 * ld));
    return __builtin_shufflevector(lo, hi, 0, 1, 2, 3, 4, 5, 6, 7);
}
template <int NT, bool A_TR, bool B_TR>
DI void mma_tile(f32x16 (&acc)[NT], const LAS bf16* A, int lda, int arow0, const LAS bf16* B, int ldb, int brow0, int K, int lane) {
#pragma unroll 2
    for (int k0 = 0; k0 < K; k0 += 16) {
        const bf16x8 a = A_TR ? frag_tr(A, lda, arow0, k0, lane) : frag_row(A, lda, arow0, k0, lane);
#pragma unroll
        for (int nt = 0; nt < NT; ++nt) {
            const bf16x8 b = B_TR ? frag_tr(B, ldb, brow0 + 32 * nt, k0, lane) : frag_row(B, ldb, brow0 + 32 * nt, k0, lane);
            acc[nt] = __builtin_amdgcn_mfma_f32_32x32x16_bf16(a, b, acc[nt], 0, 0, 0);
        }
    }
}
DI void zero16(f32x16& a) {
#pragma unroll
    for (int i = 0; i < 16; ++i) a[i] = 0.f;
}

DI void transpose_item(const float* W, int K, int N, bf16* WT, int mode, LAS float* scr, int item, int lane) {
    const int Ndst = mode == 1 ? NINP : N;
    const int nblk = Ndst / 32, kb = item / nblk, nb = item % nblk, k0 = 64 * kb, n0 = 32 * nb;
    const int nd = n0 + (lane & 31); int ns = nd; bool valid = true;
    if (mode == 1) { if (nd < 2560) ns = nd; else if (nd < 5632) ns = nd + 16; else if (nd < 5648) ns = nd - 5632 + 2560; else { valid = false; ns = 0; } }
#pragma unroll 8
    for (int i = 0; i < 32; ++i) { const int kk = 2 * i + (lane >> 5); scr[kk * 33 + (lane & 31)] = valid ? W[(size_t)(k0 + kk) * N + ns] : 0.f; }
    asm volatile("s_waitcnt lgkmcnt(0)" ::: "memory");
    const int c = lane & 7;
#pragma unroll
    for (int j = 0; j < 4; ++j) { const int n = (lane >> 3) + 8 * j; const LAS float* s = scr + (8 * c) * 33 + n;
        u32x4 o; o.x = cvtpk(s[0 * 33], s[1 * 33]); o.y = cvtpk(s[2 * 33], s[3 * 33]); o.z = cvtpk(s[4 * 33], s[5 * 33]); o.w = cvtpk(s[6 * 33], s[7 * 33]);
        *(u32x4*)(WT + (size_t)(n0 + n) * K + k0 + 8 * c) = o; }
    asm volatile("s_waitcnt lgkmcnt(0)" ::: "memory");
}
DI void p0_prologue(const Args& a, LAS unsigned char* lds, int wave, int lane) {
    unsigned char* ws = a.ws;
    LAS float* scr = (LAS float*)(lds + wave * 16384);
    const int gw = blockIdx.x * 8 + wave, NGW = gridDim.x * 8;
    constexpr int I_IN = 16 * (NINP / 32), I_OUT = 32 * 32, I_UP = 16 * 176, I_DN = 44 * 32;
    for (int it = gw; it < I_IN + I_OUT + I_UP + I_DN; it += NGW) {
        int r = it;
        if (r < I_IN) { transpose_item(a.in[2], 1024, 5648, (bf16*)(ws + WS_WIN), 1, scr, r, lane); continue; } r -= I_IN;
        if (r < I_OUT) { transpose_item(a.in[10], 2048, 1024, (bf16*)(ws + WS_WOUT), 0, scr, r, lane); continue; } r -= I_OUT;
        if (r < I_UP) { transpose_item(a.in[13], 1024, 5632, (bf16*)(ws + WS_WUP), 0, scr, r, lane); continue; } r -= I_UP;
        transpose_item(a.in[16], 2816, 1024, (bf16*)(ws + WS_WDN), 0, scr, r, lane);
    }
    const float* x = a.in[0]; const f32x4* w4 = (const f32x4*)a.in[1]; bf16* H = (bf16*)(ws + WS_R1);
    f32x4 wv[4];
#pragma unroll
    for (int j = 0; j < 4; ++j) wv[j] = w4[lane + 64 * j];
    for (int m = gw; m < T_TOK; m += NGW) {
        const f32x4* xr = (const f32x4*)(x + (size_t)m * DM) + lane;
        f32x4 v[4]; float s = 0.f;
#pragma unroll
        for (int j = 0; j < 4; ++j) { v[j] = xr[64 * j]; s += (v[j].x * v[j].x + v[j].y * v[j].y) + (v[j].z * v[j].z + v[j].w * v[j].w); }
        const float rstd = rsqrtf(wave_sum(s) * (1.f / DM) + EPS);
        u32x2* o = (u32x2*)(H + (size_t)m * DM) + lane;
#pragma unroll
        for (int j = 0; j < 4; ++j) { u32x2 w; w.x = cvtpk(v[j].x * rstd * wv[j].x, v[j].y * rstd * wv[j].y); w.y = cvtpk(v[j].z * rstd * wv[j].z, v[j].w * rstd * wv[j].w); o[64 * j] = w; }
    }
}

DI void ssd_conv8(const bf16* PROJ, const float* cw, const float* cb, int trow, int pos, int pcol, int xc, float (&o)[8]) {
    u32x4 v[4];
#pragma unroll
    for (int j = 0; j < 4; ++j) { int rr = trow - 3 + j; rr = rr < 0 ? 0 : rr; v[j] = *(const u32x4*)(PROJ + (size_t)rr * LDP + pcol); }
    const f32x4 b0 = *(const f32x4*)(cb + xc), b1 = *(const f32x4*)(cb + xc + 4);
    float acc[8] = {b0.x, b0.y, b0.z, b0.w, b1.x, b1.y, b1.z, b1.w};
#pragma unroll
    for (int j = 0; j < 4; ++j) {
        const float mk = (pos - 3 + j >= 0) ? 1.f : 0.f;
        const f32x4 w0 = *(const f32x4*)(cw + j * 1536 + xc) * mk, w1 = *(const f32x4*)(cw + j * 1536 + xc + 4) * mk;
        float f[8]; unpack8(v[j], f);
        acc[0] += w0.x * f[0]; acc[1] += w0.y * f[1]; acc[2] += w0.z * f[2]; acc[3] += w0.w * f[3];
        acc[4] += w1.x * f[4]; acc[5] += w1.y * f[5]; acc[6] += w1.z * f[6]; acc[7] += w1.w * f[7];
    }
#pragma unroll
    for (int e = 0; e < 8; ++e) o[e] = silu(acc[e]);
}
DI void rotary8(const u32x4 v1, const u32x4 v2, int pos, int dg, float scale, u32x4& o1, u32x4& o2) {
    float a[8], b[8], r1[8], r2[8]; unpack8(v1, a); unpack8(v2, b);
#pragma unroll
    for (int e = 0; e < 8; ++e) {
        const float inv = exp2f(-(float)(dg + e) * 0.41524101186092f);
        const float ang = (float)pos * inv;
        const float n = rintf(ang * 0.15915494309189535f);
        float r = fmaf(-n, 6.28125f, ang); r = fmaf(-n, 1.9353071795864769e-3f, r);
        const float sn = __sinf(r), cs = __cosf(r);
        r1[e] = (a[e] * cs - b[e] * sn) * scale; r2[e] = (b[e] * cs + a[e] * sn) * scale;
    }
    o1 = pack8(r1); o2 = pack8(r2);
}
DI void chunk_prep(const Args& a, const float* DT, int bc, LAS float* dtl, LAS float* acs, int wave, int lane) {
    const int t0 = bc * 128;
#pragma unroll
    for (int hh = 0; hh < 2; ++hh) {
        const int h = 2 * wave + hh, l0 = 2 * lane;
        const float bias = a.in[5][h], av = -expf(a.in[6][h]);
        const float d0 = softplus(DT[(size_t)(t0 + l0) * 16 + h] + bias), d1 = softplus(DT[(size_t)(t0 + l0 + 1) * 16 + h] + bias);
        const float x0 = d0 * av, x1 = x0 + d1 * av;
        float s = x1;
#pragma unroll
        for (int off = 1; off < 64; off <<= 1) { const float v = __shfl_up(s, off); if (lane >= off) s += v; }
        const float ex = s - x1;
        acs[h * 128 + l0] = ex + x0; acs[h * 128 + l0 + 1] = ex + x1; dtl[h * 128 + l0] = d0; dtl[h * 128 + l0 + 1] = d1;
    }
}

DI void p2_chunk(const Args& a, LAS unsigned char* lds, int bc, int tid, int wave, int lane) {
    unsigned char* ws = a.ws;
    const bf16* PROJ = (const bf16*)(ws + WS_BIG); const float* DT = (const float*)(ws + WS_DT); float* CD = (float*)(ws + WS_CD);
    bf16* STS = (bf16*)(ws + WS_R1); bf16* STR = (bf16*)(ws + WS_R1 + STS_BYTES);
    LAS float* dtl = (LAS float*)lds; LAS float* acs = (LAS float*)(lds + 8192);
    LAS bf16* T1 = (LAS bf16*)(lds + 16384);
    LAS bf16* T2 = (LAS bf16*)(lds + 16384 + 73728);
    const int t0 = bc * 128, pos0 = (bc & 63) * 128;
    __syncthreads();
    chunk_prep(a, DT, bc, dtl, acs, wave, lane);
    __syncthreads();
    if (tid < 16) CD[bc * 16 + tid] = __expf(acs[tid * 128 + 127]);
    const float* cw = a.in[3]; const float* cb = a.in[4];
    for (int g = 0; g < 2; ++g) {
#pragma unroll 1
        for (int r = 0; r < 4; ++r) { const int it = tid + NTHR * r, l = it >> 4, c8 = (it & 15) * 8; float o[8];
            ssd_conv8(PROJ, cw, cb, t0 + l, pos0 + l, PC_B + g * 128 + c8, 1024 + g * 128 + c8, o);
            *(LAS u32x4*)(T2 + l * 160 + c8) = pack8(o); }
        for (int hh = 0; hh < 2; ++hh) {
#pragma unroll 1
            for (int r = 0; r < 8; ++r) { const int it = tid + NTHR * r, l = it >> 5, col = (it & 31) * 8, h = g * 8 + hh * 4 + (col >> 6), xc = h * 64 + (col & 63); float o[8];
                ssd_conv8(PROJ, cw, cb, t0 + l, pos0 + l, PC_X + xc, xc, o);
                const float sc = dtl[h * 128 + l] * __expf(acs[h * 128 + 127] - acs[h * 128 + l]);
#pragma unroll
                for (int e = 0; e < 8; ++e) o[e] *= sc;
                *(LAS u32x4*)(T1 + l * 288 + col) = pack8(o); }
            __syncthreads();
            f32x16 acc[4];
#pragma unroll
            for (int nt = 0; nt < 4; ++nt) zero16(acc[nt]);
            mma_tile<4, true, true>(acc, T1, 288, wave * 32, T2, 160, 0, 128, lane);
            { const int h = g * 8 + hh * 4 + (wave >> 1); bf16* S = STS + (size_t)(bc * 16 + h) * 8192;
#pragma unroll
              for (int nt = 0; nt < 4; ++nt)
#pragma unroll
                for (int reg = 0; reg < 16; ++reg) { const int p = (wave & 1) * 32 + crow(reg, lane >> 5), n = nt * 32 + (lane & 31); S[p * 128 + n] = f2bf(acc[nt][reg]); } }
            __syncthreads();
        }
    }
    for (int hp = 0; hp < 4; ++hp) {
#pragma unroll
        for (int r = 0; r < 8; ++r) { const int it = tid + NTHR * r, l = it >> 5, col = (it & 31) * 8;
            *(LAS u32x4*)(T1 + l * 288 + col) = *(const u32x4*)(PROJ + (size_t)(t0 + l) * LDP + PC_V + hp * 256 + col); }
#pragma unroll
        for (int r = 0; r < 2; ++r) { const int it = tid + NTHR * r, l = it >> 3, i = (it >> 2) & 1, dg = (it & 3) * 8, h = 2 * hp + i;
            const bf16* kp = PROJ + (size_t)(t0 + l) * LDP + PC_K + h * 64 + dg;
            const u32x4 k1 = *(const u32x4*)kp, k2 = *(const u32x4*)(kp + 32); u32x4 o1, o2;
            rotary8(k1, k2, pos0 + l, dg, 0.125f * __expf(ret_lg(h) * (float)(127 - l)), o1, o2);
            *(LAS u32x4*)(T2 + l * 160 + i * 64 + dg) = o1; *(LAS u32x4*)(T2 + l * 160 + i * 64 + 32 + dg) = o2; }
        __syncthreads();
        f32x16 acc[2]; zero16(acc[0]); zero16(acc[1]);
        const int i = wave >> 2;
        mma_tile<2, true, true>(acc, T1, 288, i * 128 + (wave & 3) * 32, T2, 160, i * 64, 128, lane);
        { bf16* S = STR + (size_t)(bc * 8 + 2 * hp + i) * 8192;
#pragma unroll
          for (int nt = 0; nt < 2; ++nt)
#pragma unroll
            for (int reg = 0; reg < 16; ++reg) { const int e = (wave & 3) * 32 + crow(reg, lane >> 5), d = nt * 32 + (lane & 31); S[e * 64 + d] = f2bf(acc[nt][reg]); } }
        __syncthreads();
    }
}

DI void p3_scan(const Args& a, int tid) {
    unsigned char* ws = a.ws;
    bf16* STS = (bf16*)(ws + WS_R1); bf16* STR = (bf16*)(ws + WS_R1 + STS_BYTES); const float* CD = (const float*)(ws + WS_CD);
    const int nth = gridDim.x * NTHR;
    for (int it = blockIdx.x * NTHR + tid; it < 98304; it += nth) {
        bf16* base; size_t stride; const float* cdp = nullptr; float cdec = 0.f;
        if (it < 65536) { const int b = it >> 14, h = (it >> 10) & 15, v = it & 1023; base = STS + ((size_t)(b * 64) * 16 + h) * 8192 + v * 8; stride = (size_t)16 * 8192; cdp = CD + (b * 64) * 16 + h; }
        else { const int j = it - 65536, b = j >> 13, h = (j >> 10) & 7, v = j & 1023; base = STR + ((size_t)(b * 64) * 8 + h) * 8192 + v * 8; stride = (size_t)8 * 8192; cdec = __expf(ret_lg(h) * 128.f); }
        float run[8];
#pragma unroll
        for (int e = 0; e < 8; ++e) run[e] = 0.f;
#pragma unroll 1
        for (int c0 = 0; c0 < 64; c0 += 8) {
            u32x4 s[8]; float dec[8];
#pragma unroll
            for (int k = 0; k < 8; ++k) { s[k] = *(const u32x4*)(base + (size_t)(c0 + k) * stride); dec[k] = cdp ? cdp[(c0 + k) * 16] : cdec; }
#pragma unroll
            for (int k = 0; k < 8; ++k) { float f[8]; unpack8(s[k], f); *(u32x4*)(base + (size_t)(c0 + k) * stride) = pack8(run);
#pragma unroll
                for (int e = 0; e < 8; ++e) run[e] = run[e] * dec[k] + f[e]; }
        }
    }
}

DI void p4_ssd_chunk(const Args& a, LAS unsigned char* lds, int bc, int tid, int wave, int lane) {
    unsigned char* ws = a.ws;
    const bf16* PROJ = (const bf16*)(ws + WS_BIG); const float* DT = (const float*)(ws + WS_DT);
    const bf16* STS = (const bf16*)(ws + WS_R1); const bf16* STR = (const bf16*)(ws + WS_R1 + STS_BYTES);
    bf16* YM = (bf16*)a.out;
    LAS float* dtl = (LAS float*)lds; LAS float* acs = (LAS float*)(lds + 8192);
    LAS float* ssq = (LAS float*)(lds + 16384);
    LAS float* ssr = (LAS float*)(lds + 16384 + 512);
    constexpr int BASE = 20992;
    LAS bf16* Cg = (LAS bf16*)(lds + BASE);
    LAS bf16* Gm = (LAS bf16*)(lds + BASE + 34816);
    LAS bf16* XT = (LAS bf16*)(lds + BASE + 69632);
    LAS bf16* PV = (LAS bf16*)(lds + BASE + 94208);
    LAS bf16* Yt = (LAS bf16*)(lds + BASE + 111616);
    LAS bf16* Qm = (LAS bf16*)(lds + BASE);
    LAS bf16* Km = (LAS bf16*)(lds + BASE + 18432);
    LAS bf16* Pm = (LAS bf16*)(lds + BASE + 36864);
    LAS bf16* Vm = (LAS bf16*)(lds + BASE + 71680);
    LAS bf16* PT = (LAS bf16*)(lds + BASE + 112640);
    const int t0 = bc * 128, pos0 = (bc & 63) * 128, hl = lane >> 5, mt = wave >> 1, wn = wave & 1;
    __syncthreads();
    chunk_prep(a, DT, bc, dtl, acs, wave, lane);
    for (int i = tid; i < 128; i += NTHR) ssq[i] = 0.f;
    const float* cw = a.in[3]; const float* cb = a.in[4];
#ifndef P4_SSD
#define P4_SSD 2
#endif
#ifndef P4_RET
#define P4_RET 8
#endif
    for (int g = 0; g < P4_SSD; ++g) {
        __syncthreads();
#pragma unroll 1
        for (int r = 0; r < 4; ++r) { const int it = tid + NTHR * r, l = it >> 4, c8 = (it & 15) * 8; float o[8];
            ssd_conv8(PROJ, cw, cb, t0 + l, pos0 + l, PC_C + g * 128 + c8, 1280 + g * 128 + c8, o);
            *(LAS u32x4*)(Cg + l * 136 + c8) = pack8(o);
            ssd_conv8(PROJ, cw, cb, t0 + l, pos0 + l, PC_B + g * 128 + c8, 1024 + g * 128 + c8, o);
            *(LAS u32x4*)(Gm + l * 136 + c8) = pack8(o); }
        __syncthreads();
        f32x16 cbm[2]; zero16(cbm[0]); zero16(cbm[1]);
        mma_tile<2, false, false>(cbm, Cg, 136, mt * 32, Gm, 136, wn * 64, 128, lane);
        __syncthreads();
        for (int hi = 0; hi < 8; ++hi) {
            int h = g * 8 + hi; asm volatile("" : "+v"(h));
            u32x4 zpre[2];
#pragma unroll
            for (int r = 0; r < 2; ++r) { const int it = tid + NTHR * r; zpre[r] = *(const u32x4*)(PROJ + (size_t)(t0 + (it >> 3)) * LDP + PC_Z + h * 64 + (it & 7) * 8); }
#pragma unroll 1
            for (int r = 0; r < 2; ++r) { const int it = tid + NTHR * r, l = it >> 3, c8 = (it & 7) * 8, xc = h * 64 + c8; float o[8];
                ssd_conv8(PROJ, cw, cb, t0 + l, pos0 + l, PC_X + xc, xc, o);
                *(LAS u32x4*)(XT + l * 96 + c8) = pack8(o); }
#pragma unroll
            for (int r = 0; r < 2; ++r) { const int it = tid + NTHR * r, p = it >> 4, c8 = (it & 15) * 8;
                *(LAS u32x4*)(PV + p * 136 + c8) = *(const u32x4*)(STS + (size_t)(bc * 16 + h) * 8192 + p * 128 + c8); }
#pragma unroll
            for (int nt = 0; nt < 2; ++nt) { const int s = wn * 64 + nt * 32 + (lane & 31); const float as = acs[h * 128 + s], ds = dtl[h * 128 + s];
#pragma unroll
                for (int reg = 0; reg < 16; ++reg) { const int l = mt * 32 + crow(reg, hl);
                    const float v = (l >= s) ? cbm[nt][reg] * __expf(acs[h * 128 + l] - as) * ds : 0.f;
                    Gm[l * 136 + s] = f2bf(v); } }
            __syncthreads();
            f32x16 y1[1]; zero16(y1[0]);
            mma_tile<1, false, false>(y1, Cg, 136, mt * 32, PV, 136, wn * 32, 128, lane);
#pragma unroll
            for (int reg = 0; reg < 16; ++reg) y1[0][reg] *= __expf(acs[h * 128 + mt * 32 + crow(reg, hl)]);
            mma_tile<1, false, true>(y1, Gm, 136, mt * 32, XT, 96, wn * 32, 128, lane);
            { const float dsk = a.in[7][h]; const int p = wn * 32 + (lane & 31);
#pragma unroll
              for (int reg = 0; reg < 16; ++reg) { const int l = mt * 32 + crow(reg, hl);
                  const float y = y1[0][reg] + dsk * bf2f(XT[l * 96 + p]);
                  Yt[l * 72 + p] = f2bf(y); } }
            __syncthreads();
#pragma unroll
            for (int r = 0; r < 2; ++r) { const int it = tid + NTHR * r, l = it >> 3, c8 = (it & 7) * 8; float y[8], z[8];
                unpack8(*(const LAS u32x4*)(Yt + l * 72 + c8), y); unpack8(zpre[r], z);
                float q = 0.f;
#pragma unroll
                for (int e = 0; e < 8; ++e) { y[e] *= silu(z[e]); q += y[e] * y[e]; }
                q += __shfl_xor(q, 1); q += __shfl_xor(q, 2); q += __shfl_xor(q, 4);
                if ((lane & 7) == 0) atomicAdd((float*)(ssq + l), q);
                *(u32x4*)(YM + (size_t)(t0 + l) * 2048 + h * 64 + c8) = pack8(y); }
        }
    }
    __syncthreads();
    { const float* nw = a.in[8];
#pragma unroll 1
      for (int r = 0; r < 32; ++r) { const int it = tid + NTHR * r, l = it >> 7, c8 = (it & 127) * 8;
          const float rstd = rsqrtf(ssq[l] * (1.f / 1024.f) + EPS);
          bf16* yp = YM + (size_t)(t0 + l) * 2048 + c8; float f[8]; unpack8(*(const u32x4*)yp, f);
          const f32x4 w0 = *(const f32x4*)(nw + c8), w1 = *(const f32x4*)(nw + c8 + 4);
          f[0] *= rstd * w0.x; f[1] *= rstd * w0.y; f[2] *= rstd * w0.z; f[3] *= rstd * w0.w; f[4] *= rstd * w1.x; f[5] *= rstd * w1.y; f[6] *= rstd * w1.z; f[7] *= rstd * w1.w;
          *(u32x4*)yp = pack8(f); } }
}

DI void p4_ret_chunk(const Args& a, LAS unsigned char* lds, int bc, int tid, int wave, int lane) {
    unsigned char* ws = a.ws;
    const bf16* PROJ = (const bf16*)(ws + WS_BIG);
    const bf16* STR = (const bf16*)(ws + WS_R1 + STS_BYTES);
    bf16* YM = (bf16*)a.out;
    LAS float* ssr = (LAS float*)(lds + 16384 + 512);
    constexpr int BASE = 20992;
    LAS bf16* Qm = (LAS bf16*)(lds + BASE);
    LAS bf16* Km = (LAS bf16*)(lds + BASE + 18432);
    LAS bf16* Pm = (LAS bf16*)(lds + BASE + 36864);
    LAS bf16* Vm = (LAS bf16*)(lds + BASE + 71680);
    LAS bf16* PT = (LAS bf16*)(lds + BASE + 112640);
    const int t0 = bc * 128, pos0 = (bc & 63) * 128, hl = lane >> 5, mt = wave >> 1, wn = wave & 1;
    __syncthreads();
    for (int i = tid; i < 1024; i += NTHR) ssr[i] = 0.f;
    for (int h = 0; h < P4_RET; ++h) {
        const float lg = ret_lg(h);
        __syncthreads();
        { const int l = tid >> 2, dg = (tid & 3) * 8;
          const bf16* qp = PROJ + (size_t)(t0 + l) * LDP + PC_Q + h * 64 + dg; const bf16* kp = PROJ + (size_t)(t0 + l) * LDP + PC_K + h * 64 + dg;
          u32x4 o1, o2;
          rotary8(*(const u32x4*)qp, *(const u32x4*)(qp + 32), pos0 + l, dg, 1.f, o1, o2);
          *(LAS u32x4*)(Qm + l * 72 + dg) = o1; *(LAS u32x4*)(Qm + l * 72 + 32 + dg) = o2;
          rotary8(*(const u32x4*)kp, *(const u32x4*)(kp + 32), pos0 + l, dg, 0.125f, o1, o2);
          *(LAS u32x4*)(Km + l * 72 + dg) = o1; *(LAS u32x4*)(Km + l * 72 + 32 + dg) = o2; }
        u32x4 gpre[4];
#pragma unroll
        for (int r = 0; r < 4; ++r) { const int it = tid + NTHR * r; gpre[r] = *(const u32x4*)(PROJ + (size_t)(t0 + (it >> 4)) * LDP + PC_G + h * 128 + (it & 15) * 8); }
#pragma unroll
        for (int r = 0; r < 4; ++r) { const int it = tid + NTHR * r, l = it >> 4, c8 = (it & 15) * 8;
            *(LAS u32x4*)(Vm + l * 160 + c8) = *(const u32x4*)(PROJ + (size_t)(t0 + l) * LDP + PC_V + h * 128 + c8); }
#pragma unroll
        for (int r = 0; r < 2; ++r) { const int it = tid + NTHR * r, e = it >> 3, c8 = (it & 7) * 8;
            *(LAS u32x4*)(PT + e * 72 + c8) = *(const u32x4*)(STR + (size_t)(bc * 8 + h) * 8192 + e * 64 + c8); }
        __syncthreads();
        { f32x16 sc[2]; zero16(sc[0]); zero16(sc[1]);
          mma_tile<2, false, false>(sc, Qm, 72, mt * 32, Km, 72, wn * 64, 64, lane);
#pragma unroll
          for (int nt = 0; nt < 2; ++nt) { const int s = wn * 64 + nt * 32 + (lane & 31);
#pragma unroll
              for (int reg = 0; reg < 16; ++reg) { const int l = mt * 32 + crow(reg, hl);
                  const float v = (l >= s) ? sc[nt][reg] * __expf(lg * (float)(l - s)) : 0.f;
                  Pm[l * 136 + s] = f2bf(v); } } }
        __syncthreads();
        f32x16 oi[2]; zero16(oi[0]); zero16(oi[1]);
        mma_tile<2, false, false>(oi, Qm, 72, mt * 32, PT, 72, wn * 64, 64, lane);
#pragma unroll
        for (int reg = 0; reg < 16; ++reg) { const float qd = __expf(lg * (float)(mt * 32 + crow(reg, hl) + 1)); oi[0][reg] *= qd; oi[1][reg] *= qd; }
        mma_tile<2, false, true>(oi, Pm, 136, mt * 32, Vm, 160, wn * 64, 128, lane);
#pragma unroll
        for (int reg = 0; reg < 16; ++reg) { const int l = mt * 32 + crow(reg, hl);
            const float q = half_sum32(oi[0][reg] * oi[0][reg] + oi[1][reg] * oi[1][reg]);
            if ((lane & 31) == 0) atomicAdd((float*)(ssr + h * 128 + l), q); }
        __syncthreads();
        { const float* rw = a.in[9];
#pragma unroll
          for (int nt = 0; nt < 2; ++nt) { const int e = wn * 64 + nt * 32 + (lane & 31); const float wv = rw[h * 128 + e];
#pragma unroll
              for (int reg = 0; reg < 16; ++reg) { const int l = mt * 32 + crow(reg, hl);
                  const float rstd = rsqrtf(ssr[h * 128 + l] * (1.f / 128.f) + EPS);
                  Pm[l * 136 + e] = f2bf(oi[nt][reg] * rstd * wv); } } }
        __syncthreads();
#pragma unroll
        for (int r = 0; r < 4; ++r) { const int it = tid + NTHR * r, l = it >> 4, c8 = (it & 15) * 8; float o[8], gv[8];
            unpack8(*(const LAS u32x4*)(Pm + l * 136 + c8), o); unpack8(gpre[r], gv);
#pragma unroll
            for (int e = 0; e < 8; ++e) o[e] *= silu(gv[e]);
            *(u32x4*)(YM + (size_t)(t0 + l) * 2048 + 1024 + h * 128 + c8) = pack8(o); }
    }
}

DI void p6_norm(const Args& a, int wave, int lane) {
    unsigned char* ws = a.ws;
    const float* Y = (const float*)(ws + WS_BIG); bf16* H = (bf16*)(ws + WS_R1);
    const int gw = blockIdx.x * 8 + wave, NGW = gridDim.x * 8;
    const f32x4* w1p = (const f32x4*)a.in[11]; const f32x4* w2p = (const f32x4*)a.in[12];
    f32x4 w1[4], w2[4];
#pragma unroll
    for (int j = 0; j < 4; ++j) { w1[j] = w1p[lane + 64 * j]; w2[j] = w2p[lane + 64 * j]; }
    for (int m = gw; m < T_TOK; m += NGW) {
        const f32x4* yr = (const f32x4*)(Y + (size_t)m * DM) + lane; const f32x4* xr = (const f32x4*)(a.in[0] + (size_t)m * DM) + lane;
        f32x4 y[4], x[4]; float s = 0.f;
#pragma unroll
        for (int j = 0; j < 4; ++j) { y[j] = yr[64 * j]; x[j] = xr[64 * j]; s += (y[j].x * y[j].x + y[j].y * y[j].y) + (y[j].z * y[j].z + y[j].w * y[j].w); }
        const float rstd = rsqrtf(wave_sum(s) * (1.f / DM) + EPS); float s2 = 0.f;
        f32x4* orow = (f32x4*)(a.out + (size_t)m * DM) + lane;
#pragma unroll
        for (int j = 0; j < 4; ++j) { x[j] = x[j] + y[j] * rstd * w1[j]; orow[64 * j] = x[j]; s2 += (x[j].x * x[j].x + x[j].y * x[j].y) + (x[j].z * x[j].z + x[j].w * x[j].w); }
        const float rstd2 = rsqrtf(wave_sum(s2) * (1.f / DM) + EPS);
        u32x2* o = (u32x2*)(H + (size_t)m * DM) + lane;
#pragma unroll
        for (int j = 0; j < 4; ++j) { u32x2 w; w.x = cvtpk(x[j].x * rstd2 * w2[j].x, x[j].y * rstd2 * w2[j].y); w.y = cvtpk(x[j].z * rstd2 * w2[j].z, x[j].w * rstd2 * w2[j].w); o[64 * j] = w; }
    }
}

DI void p8_act(const Args& a, int tid) {
    bf16* UP = (bf16*)(a.ws + WS_BIG); const float* cw = a.in[14]; const float* cb = a.in[15];
    for (int bc = blockIdx.x; bc < NCHUNK; bc += gridDim.x) {
#pragma unroll 1
        for (int r = 0; r < 6; ++r) { const int it = tid + NTHR * r; if (it >= 2816) break;
            const int cgi = it % 352, sub = it / 352, c0 = cgi * 8, t = bc * 128 + sub * 16, pos = (bc & 63) * 128 + sub * 16;
            float w[3][8], b[8];
#pragma unroll
            for (int j = 0; j < 3; ++j) { const f32x4 u0 = *(const f32x4*)(cw + j * DFF + c0), u1 = *(const f32x4*)(cw + j * DFF + c0 + 4);
                w[j][0] = u0.x; w[j][1] = u0.y; w[j][2] = u0.z; w[j][3] = u0.w; w[j][4] = u1.x; w[j][5] = u1.y; w[j][6] = u1.z; w[j][7] = u1.w; }
            { const f32x4 u0 = *(const f32x4*)(cb + c0), u1 = *(const f32x4*)(cb + c0 + 4); b[0] = u0.x; b[1] = u0.y; b[2] = u0.z; b[3] = u0.w; b[4] = u1.x; b[5] = u1.y; b[6] = u1.z; b[7] = u1.w; }
            float g2[8], g1[8];
            if (pos >= 2) { unpack8(*(const u32x4*)(UP + (size_t)(t - 2) * LDU + c0), g2); unpack8(*(const u32x4*)(UP + (size_t)(t - 1) * LDU + c0), g1); }
            else {
#pragma unroll
                for (int e = 0; e < 8; ++e) { g2[e] = 0.f; g1[e] = 0.f; } }
#pragma unroll 4
            for (int k = 0; k < 16; ++k) { bf16* rowp = UP + (size_t)(t + k) * LDU + c0;
                float g0[8], v[8], o[8]; unpack8(*(const u32x4*)rowp, g0); unpack8(*(const u32x4*)(rowp + DFF), v);
#pragma unroll
                for (int e = 0; e < 8; ++e) { const float s = b[e] + w[0][e] * g2[e] + w[1][e] * g1[e] + w[2][e] * g0[e]; o[e] = silu(s) * v[e]; g2[e] = g1[e]; g1[e] = g0[e]; }
                *(u32x4*)(rowp + DFF) = pack8(o); }
        }
    }
}

DI void p10_final(const Args& a, int wave, int lane, int nprobe) {
    const bf16* F = (const bf16*)(a.ws + WS_R1);
    const int gw = blockIdx.x * 8 + wave, NGW = gridDim.x * 8;
    const float* wp = a.in[17];
    for (int m = gw; m < T_TOK; m += NGW) {
        float f[2][8]; float s = 0.f;
#pragma unroll
        for (int j = 0; j < 2; ++j) { unpack8(*(const u32x4*)(F + (size_t)m * DM + (lane + 64 * j) * 8), f[j]);
#pragma unroll
            for (int e = 0; e < 8; ++e) s += f[j][e] * f[j][e]; }
        const float rstd = rsqrtf(wave_sum(s) * (1.f / DM) + EPS);
#pragma unroll
        for (int j = 0; j < 2; ++j) { float* op = a.out + (size_t)m * DM + (lane + 64 * j) * 8; const float* wq = wp + (lane + 64 * j) * 8;
            f32x4 x0 = *(const f32x4*)op, x1 = *(const f32x4*)(op + 4); const f32x4 w0 = *(const f32x4*)wq, w1 = *(const f32x4*)(wq + 4);
            x0.x += f[j][0] * rstd * w0.x; x0.y += f[j][1] * rstd * w0.y; x0.z += f[j][2] * rstd * w0.z; x0.w += f[j][3] * rstd * w0.w;
            x1.x += f[j][4] * rstd * w1.x; x1.y += f[j][5] * rstd * w1.y; x1.z += f[j][6] * rstd * w1.z; x1.w += f[j][7] * rstd * w1.w;
            if ((lane & 7) == 0 && m * 16 + (lane >> 3) + 8 * j < nprobe) x1.w += 0.125f;
            *(f32x4*)op = x0; *(f32x4*)(op + 4) = x1; }
    }
}

constexpr int N_PHASES = 11;
__global__ void __launch_bounds__(NTHR, 2) hymba_fwd(Args args) {
    extern __shared__ __attribute__((aligned(16))) unsigned char lds_raw[];
    LAS unsigned char* lds = (LAS unsigned char*)lds_raw;
    const int tid = threadIdx.x, lane = tid & 63, wave = __builtin_amdgcn_readfirstlane(tid >> 6);
    unsigned char* ws = args.ws;
    const int lo = args.ph_lo, hi = args.ph_hi;
#ifndef PHMASK
#define PHMASK 0x7ff
#endif
#define IN(k) (((PHMASK >> (k)) & 1) && lo <= (k) && (k) < hi)
#ifdef PROBE_A
#define STAMP(k) do { if (tid == 0) *(LAS unsigned long long*)(lds + 155520 + 8 * (k)) = (unsigned long long)__builtin_amdgcn_s_memrealtime(); } while (0)
#else
#define STAMP(k) do { } while (0)
#endif
#define SEAM(k) do { if (IN(k) && IN((k) + 1)) { cgrp::this_grid().sync(); } STAMP((k) + 1); } while (0)
    STAMP(0);
    if (IN(0)) { p0_prologue(args, lds, wave, lane); }
    SEAM(0);
    if (IN(1)) {
        pg8::Gemm g{(const bf16*)(ws + WS_R1), (const bf16*)(ws + WS_WIN), T_TOK, NINP, 1024, 1024}; pg8::StaticOrder S; S.init(T_TOK, NINP, gridDim.x, (int)blockIdx.x);
        pg8::EpiProj E{(bf16*)(ws + WS_BIG), (float*)(ws + WS_DT)};
        pg8::gemm_phase<pg8::EpiProj, pg8::StaticOrder, true, true>(lds, g, S, E);
    }
    SEAM(1);
    if (IN(2)) { for (int bc = blockIdx.x; bc < NCHUNK; bc += gridDim.x) p2_chunk(args, lds, bc, tid, wave, lane); }
    SEAM(2);
    if (IN(3)) { p3_scan(args, tid); }
    SEAM(3);
    if (IN(4)) { for (int bc = blockIdx.x; bc < NCHUNK; bc += gridDim.x) p4_ssd_chunk(args, lds, bc, tid, wave, lane);
                 for (int bc = blockIdx.x; bc < NCHUNK; bc += gridDim.x) p4_ret_chunk(args, lds, bc, tid, wave, lane); }
    SEAM(4);
    if (IN(5)) {
        __syncthreads();
        pg8::Gemm g{(const bf16*)args.out, (const bf16*)(ws + WS_WOUT), T_TOK, 1024, 2048, 2048}; pg8::StaticOrder S; S.init(T_TOK, 1024, gridDim.x, (int)blockIdx.x);
        pg8::EpiF32 E{(float*)(ws + WS_BIG), 1024};
        pg8::gemm_phase<pg8::EpiF32, pg8::StaticOrder, true, true>(lds, g, S, E);
    }
    SEAM(5);
    if (IN(6)) { p6_norm(args, wave, lane); }
    SEAM(6);
    if (IN(7)) {
        pg8::Gemm g{(const bf16*)(ws + WS_R1), (const bf16*)(ws + WS_WUP), T_TOK, 5632, 1024, 1024}; pg8::StaticOrder S; S.init(T_TOK, 5632, gridDim.x, (int)blockIdx.x);
        pg8::EpiBf16 E{(bf16*)(ws + WS_BIG), LDU};
        pg8::gemm_phase<pg8::EpiBf16, pg8::StaticOrder, true, true>(lds, g, S, E);
    }
    SEAM(7);
    if (IN(8)) { p8_act(args, tid); }
    SEAM(8);
    if (IN(9)) {
        pg8::Gemm g{(const bf16*)(ws + WS_BIG) + DFF, (const bf16*)(ws + WS_WDN), T_TOK, 1024, 2816, LDU}; pg8::StaticOrder S; S.init(T_TOK, 1024, gridDim.x, (int)blockIdx.x);
        pg8::EpiBf16 E{(bf16*)(ws + WS_R1), 1024};
        pg8::gemm_phase<pg8::EpiBf16, pg8::StaticOrder, true, true>(lds, g, S, E);
    }
    SEAM(9);
#ifdef PROBE_A
    int nprobe = 0;
    if (IN(10)) { __syncthreads(); const unsigned long long ta = *(LAS unsigned long long*)(lds + 155520 + 8 * PROBE_A), tb = *(LAS unsigned long long*)(lds + 155520 + 8 * PROBE_B); nprobe = (int)((tb - ta) / 2); }
#else
    const int nprobe = 0;
#endif
    if (IN(10)) { p10_final(args, wave, lane, nprobe); }
#undef IN
#undef SEAM
}

#ifndef MK_ONE_LAUNCH
#define MK_ONE_LAUNCH 1
#endif
#ifndef REP_PHASE
#define REP_PHASE -1
#define REP_COUNT 1
#endif
extern "C" void kernel_launch(void* const* d_in, const int* in_sizes, int n_in, void* d_out, int out_size, void* d_ws, size_t ws_size, hipStream_t stream) {
    static int grid = 0;
    if (grid == 0) {
        if (n_in != 18 || out_size != T_TOK * DM || ws_size < WS_END) { fprintf(stderr, "kernel_launch: unexpected shapes: n_in %d out %d ws %zu (need %zu)\n", n_in, out_size, ws_size, (size_t)WS_END); grid = -1; return; }
        int dev = 0, cus = 0, per_cu = 0;
        hipGetDevice(&dev); hipDeviceGetAttribute(&cus, hipDeviceAttributeMultiprocessorCount, dev);
        if (hipFuncSetAttribute((const void*)hymba_fwd, hipFuncAttributeMaxDynamicSharedMemorySize, LDS_BYTES) != hipSuccess) { fprintf(stderr, "kernel_launch: hipFuncSetAttribute failed\n"); grid = -1; return; }
        hipOccupancyMaxActiveBlocksPerMultiprocessor(&per_cu, (const void*)hymba_fwd, NTHR, LDS_BYTES);
        if (per_cu < 1) { fprintf(stderr, "kernel_launch: occupancy query says %d blocks per CU\n", per_cu); per_cu = 1; }
        (void)hipGetLastError();
        grid = cus;
    }
    if (grid < 0) return;
    Args a{};
    for (int i = 0; i < 18; ++i) a.in[i] = (const float*)d_in[i];
    a.out = (float*)d_out; a.ws = (unsigned char*)d_ws;
#if MK_ONE_LAUNCH
    a.ph_lo = 0; a.ph_hi = N_PHASES;
    void* kargs[] = {&a};
    hipError_t e = hipLaunchCooperativeKernel((const void*)hymba_fwd, dim3(grid), dim3(NTHR), kargs, LDS_BYTES, stream);
    if (e != hipSuccess) fprintf(stderr, "cooperative launch failed: %s (grid %d)\n", hipGetErrorString(e), grid);
#else
    for (int p = 0; p < N_PHASES; ++p) {
        a.ph_lo = p; a.ph_hi = p + 1;
        const int nrep = (p == REP_PHASE) ? REP_COUNT : 1;
        for (int rr = 0; rr < nrep; ++rr) hipLaunchKernelGGL(hymba_fwd, dim3(grid), dim3(NTHR), LDS_BYTES, stream, a);
    }
#endif
}
```

```cpp
#include <hip/hip_runtime.h>
#include <hip/hip_cooperative_groups.h>
#include <cstdio>
#include <cstdint>
namespace cgrp = cooperative_groups;

namespace pg8 {
#define PG8_LAS __attribute__((address_space(3)))
typedef unsigned short bf16_t;
typedef short bf16x8 __attribute__((ext_vector_type(8)));
typedef float f32x4 __attribute__((ext_vector_type(4)));
typedef unsigned u32x4 __attribute__((ext_vector_type(4)));
constexpr int BM = 256, BK = 64, HALF = 128, HTB = HALF * BK * 2  , STAGE_BYTES = 8 * HTB, NXCD = 8, WGM = 8;

__host__ __device__ __forceinline__ int lds_byte(int r, int c) { const int st = (r >> 4) * 2 + (c >> 5), rr = r & 15, cc = c & 31, ob = rr * 64 + cc * 2; return st * 1024 + (ob ^ (((ob >> 9) & 1) << 5)); }
__host__ __device__ __forceinline__ void stage_rc(int b, int& R, int& C) { const int st = b / 1024, sb = b % 1024, swz = sb ^ (((sb >> 9) & 1) << 5); R = (st >> 1) * 16 + swz / 64; C = (st & 1) * 32 + (swz % 64) / 2; }
__host__ __device__ __forceinline__ int perm32(int rho) { const int n = rho >> 4, i = rho & 15; return 8 * (i >> 2) + 4 * n + (i & 3); }

struct Unit { int pm, pn; };
struct Gemm { const bf16_t* A; const bf16_t* Bt; int M, N, K, lda; };

struct StaticOrder {
    int nM, nN, nwg, G, c;
    __host__ __device__ void init(int M, int N, int G_, int c_) { nM = M / BM; nN = N / BM; nwg = nM * nN; G = G_; c = c_; }
    __host__ __device__ bool next(int i, Unit& u) const {
        const long L = (long)i * G + c; if (L >= nwg) return false;
        int wgid = (int)L; { const int q = nwg / NXCD, r = nwg % NXCD, xcd = wgid % NXCD, off = wgid / NXCD; wgid = (xcd < r ? xcd * (q + 1) : r * (q + 1) + (xcd - r) * q) + off; }
        const int nig = WGM * nN, gid = wgid / nig, fm = gid * WGM, gsz = (nM - fm) < WGM ? (nM - fm) : WGM;
        u.pm = fm + ((wgid % nig) % gsz); u.pn = (wgid % nig) / gsz; return true;
    }
    __device__ __forceinline__ void a_ready(const Unit&) const {}
    __device__ __forceinline__ void done(const Unit&) const {}
};

__device__ __forceinline__ unsigned cvt_pk_bf16(float lo, float hi) { unsigned r; asm volatile("v_cvt_pk_bf16_f32 %0, %1, %2" : "=v"(r) : "v"(lo), "v"(hi)); return r; }
struct EpiBf16 {
    static constexpr bool PERM = true, AFTER_DRAIN = false;
    bf16_t* O; int ldc;
    __device__ __forceinline__ void operator()(const f32x4 (&acc)[2][2][4][2], const Unit& u, int wr, int wc, int fr, int fq) const {
        const int row0 = u.pm * BM + wr * 64 + fr, col0 = u.pn * BM + wc * 32 + 8 * fq;
#pragma unroll
        for (int ai = 0; ai < 2; ++ai)
#pragma unroll
            for (int m = 0; m < 4; ++m) { bf16_t* rowp = O + (size_t)(row0 + ai * HALF + m * 16) * ldc + col0;
#pragma unroll
                for (int bj = 0; bj < 2; ++bj) { const f32x4 v0 = acc[ai][bj][m][0], v1 = acc[ai][bj][m][1];
                    u32x4 w; w.x = cvt_pk_bf16(v0[0], v0[1]); w.y = cvt_pk_bf16(v0[2], v0[3]); w.z = cvt_pk_bf16(v1[0], v1[1]); w.w = cvt_pk_bf16(v1[2], v1[3]);
                    *(u32x4*)(rowp + bj * HALF) = w; } }
    }
};
struct EpiProj {
    static constexpr bool PERM = true, AFTER_DRAIN = false;
    bf16_t* O; float* DT;
    __device__ __forceinline__ void operator()(const f32x4 (&acc)[2][2][4][2], const Unit& u, int wr, int wc, int fr, int fq) const {
        const int row0 = u.pm * BM + wr * 64 + fr;
        if (u.pn < 22) {
            const int col0 = u.pn * BM + wc * 32 + 8 * fq;
#pragma unroll
            for (int ai = 0; ai < 2; ++ai)
#pragma unroll
                for (int m = 0; m < 4; ++m) { bf16_t* rowp = O + (size_t)(row0 + ai * HALF + m * 16) * 5632 + col0;
#pragma unroll
                    for (int bj = 0; bj < 2; ++bj) { const f32x4 v0 = acc[ai][bj][m][0], v1 = acc[ai][bj][m][1];
                        u32x4 w; w.x = cvt_pk_bf16(v0[0], v0[1]); w.y = cvt_pk_bf16(v0[2], v0[3]); w.z = cvt_pk_bf16(v1[0], v1[1]); w.w = cvt_pk_bf16(v1[2], v1[3]);
                        *(u32x4*)(rowp + bj * HALF) = w; } }
        } else if (wc == 0 && fq < 2) {
#pragma unroll
            for (int ai = 0; ai < 2; ++ai)
#pragma unroll
                for (int m = 0; m < 4; ++m) { float* p = DT + (size_t)(row0 + ai * HALF + m * 16) * 16 + 8 * fq;
                    *(f32x4*)p = acc[ai][0][m][0]; *(f32x4*)(p + 4) = acc[ai][0][m][1]; }
        }
    }
};
struct EpiF32 {
    static constexpr bool PERM = true, AFTER_DRAIN = false;
    float* O; int ldc;
    __device__ __forceinline__ void operator()(const f32x4 (&acc)[2][2][4][2], const Unit& u, int wr, int wc, int fr, int fq) const {
        const int row0 = u.pm * BM + wr * 64 + fr, col0 = u.pn * BM + wc * 32 + 8 * fq;
#pragma unroll
        for (int ai = 0; ai < 2; ++ai)
#pragma unroll
            for (int m = 0; m < 4; ++m) { float* rowp = O + (size_t)(row0 + ai * HALF + m * 16) * ldc + col0;
#pragma unroll
                for (int bj = 0; bj < 2; ++bj) { *(f32x4*)(rowp + bj * HALF) = acc[ai][bj][m][0]; *(f32x4*)(rowp + bj * HALF + 4) = acc[ai][bj][m][1]; } }
    }
};
template <class Epi, class Sched, bool ALIGN_EPI = false, bool SP2 = false>
__device__ __forceinline__ void gemm_phase(PG8_LAS unsigned char* lds, const Gemm g, const Sched& S, const Epi& E) {
    const int tid = threadIdx.x, wid = __builtin_amdgcn_readfirstlane(tid >> 6), lane = tid & 63, wr = wid >> 2, wc = wid & 3, fr = lane & 15, fq = lane >> 4;
    const int K = g.K, nt = K / BK;
    unsigned voffA[2], voffB[2];
#pragma unroll
    for (int i = 0; i < 2; ++i) { int R, C; stage_rc(tid * 16 + i * 8192, R, C); const int Rb = Epi::PERM ? ((R & ~31) + perm32(R & 31)) : R;
        voffA[i] = (unsigned)(R * g.lda + C) * 2u; voffB[i] = (unsigned)(Rb * K + C) * 2u; }
    const size_t kstep = (size_t)(BK * 2);
    const size_t hstepA = (size_t)HALF * g.lda * 2, hstepB = (size_t)HALF * K * 2;
    const size_t tstepA = 2 * hstepA, tstepB = 2 * hstepB;
    const unsigned ldsw = (unsigned)wid * 1024u;
    const int aoff = lds_byte(wr * 64 + fr, fq * 8), boff = lds_byte(wc * 32 + fr, fq * 8);
#define PG8_SA(b, h) (((b) * 2 + (h)) * HTB)
#define PG8_SB(b, h) ((4 + (b) * 2 + (h)) * HTB)
#define PG8_STAGE(bufoff, gbase, voff) do { _Pragma("unroll") for (int _i = 0; _i < 2; ++_i) \
        __builtin_amdgcn_global_load_lds((const unsigned*)((const char*)(gbase) + (voff)[_i]), (PG8_LAS unsigned*)(lds + (bufoff) + ldsw + _i * 8192), 16, 0, 0); } while (0)
#define PG8_LDA(dst, b, h) do { _Pragma("unroll") for (int m = 0; m < 4; ++m) _Pragma("unroll") for (int k = 0; k < 2; ++k) dst[m][k] = *(const PG8_LAS bf16x8*)(lds + PG8_SA(b, h) + aoff + m * 2048 + k * 1024); } while (0)
#define PG8_LDB(dst, b, h) do { _Pragma("unroll") for (int n = 0; n < 2; ++n) _Pragma("unroll") for (int k = 0; k < 2; ++k) dst[n][k] = *(const PG8_LAS bf16x8*)(lds + PG8_SB(b, h) + boff + n * 2048 + k * 1024); } while (0)
#define PG8_MMA(ai, bj, At, Bt) do { __builtin_amdgcn_s_setprio(1); _Pragma("unroll") for (int m = 0; m < 4; ++m) _Pragma("unroll") for (int n = 0; n < 2; ++n) _Pragma("unroll") for (int k = 0; k < 2; ++k) \
        acc[ai][bj][m][n] = __builtin_amdgcn_mfma_f32_16x16x32_bf16(Bt[n][k], At[m][k], acc[ai][bj][m][n], 0, 0, 0); __builtin_amdgcn_s_setprio(0); } while (0)
#define PG8_WAIT_V(n) asm volatile("s_waitcnt vmcnt(" #n ")" ::: "memory")
#define PG8_WAIT_L(n) asm volatile("s_waitcnt lgkmcnt(" #n ")" ::: "memory")
#define PG8_BAR __builtin_amdgcn_s_barrier()
#define PG8_SCHED __builtin_amdgcn_sched_barrier(0)
    Unit cur, nxt; int ui = 0;
    if (!S.next(0, cur)) return;
    f32x4 acc[2][2][4][2];
#pragma unroll
    for (int a = 0; a < 2; ++a)
#pragma unroll
        for (int b = 0; b < 2; ++b)
#pragma unroll
            for (int m = 0; m < 4; ++m)
#pragma unroll
                for (int n = 0; n < 2; ++n) acc[a][b][m][n] = (f32x4){0.f, 0.f, 0.f, 0.f};
    bf16x8 At[4][2], B0[2][2], B1[2][2];
    const char* cA = (const char*)g.A + (size_t)cur.pm * tstepA; const char* cB = (const char*)g.Bt + (size_t)cur.pn * tstepB;
    S.a_ready(cur);
    if constexpr (SP2) {
        PG8_STAGE(PG8_SB(0, 0), cB, voffB); PG8_STAGE(PG8_SB(0, 1), cB + hstepB, voffB); PG8_STAGE(PG8_SA(0, 0), cA, voffA); PG8_STAGE(PG8_SA(0, 1), cA + hstepA, voffA);
        if (wr == 1) PG8_BAR;
        PG8_WAIT_V(2); PG8_BAR;
        PG8_STAGE(PG8_SB(1, 0), cB + kstep, voffB); PG8_STAGE(PG8_SA(1, 0), cA + kstep, voffA); PG8_STAGE(PG8_SB(1, 1), cB + hstepB + kstep, voffB);
        PG8_WAIT_V(6); PG8_BAR;
    } else {
        PG8_STAGE(PG8_SB(0, 0), cB, voffB); PG8_STAGE(PG8_SA(0, 0), cA, voffA); PG8_STAGE(PG8_SB(0, 1), cB + hstepB, voffB); PG8_STAGE(PG8_SA(0, 1), cA + hstepA, voffA);
        if (wr == 1) PG8_BAR;
        PG8_WAIT_V(4); PG8_BAR;
        PG8_STAGE(PG8_SB(1, 0), cB + kstep, voffB); PG8_STAGE(PG8_SA(1, 0), cA + kstep, voffA); PG8_STAGE(PG8_SB(1, 1), cB + hstepB + kstep, voffB);
        PG8_WAIT_V(6); PG8_BAR;
    }
    for (;;) {
        const bool has_next = S.next(ui + 1, nxt);
        const char* nA = has_next ? (const char*)g.A + (size_t)nxt.pm * tstepA : cA; const char* nB = has_next ? (const char*)g.Bt + (size_t)nxt.pn * tstepB : cB;
        for (int t = 0; t < nt; t += 2) {
            const bool last = (t == nt - 2);
            const char* a1 = cA + (size_t)(t + 1) * kstep;
            const char* a2 = last ? nA : cA + (size_t)(t + 2) * kstep; const char* b2 = last ? nB : cB + (size_t)(t + 2) * kstep;
            const char* a3 = a2 + kstep; const char* b3 = b2 + kstep;
            if (last && has_next) S.a_ready(nxt);
            if constexpr (SP2) {
            PG8_LDB(B0, 0, 0); PG8_LDB(B1, 0, 1); PG8_SCHED; PG8_LDA(At, 0, 0); PG8_STAGE(PG8_SA(1, 1), a1 + hstepA, voffA);
            PG8_WAIT_V(8); PG8_WAIT_L(0); PG8_BAR; PG8_MMA(0, 0, At, B0); PG8_MMA(0, 1, At, B1); PG8_BAR; PG8_SCHED;
            PG8_LDA(At, 0, 1); PG8_STAGE(PG8_SB(0, 0), b2, voffB); PG8_STAGE(PG8_SB(0, 1), b2 + hstepB, voffB); PG8_STAGE(PG8_SA(0, 0), a2, voffA);
            PG8_WAIT_V(8); PG8_WAIT_L(0); PG8_BAR; PG8_MMA(1, 0, At, B0); PG8_MMA(1, 1, At, B1); PG8_BAR; PG8_SCHED;
            PG8_LDB(B0, 1, 0); PG8_LDB(B1, 1, 1); PG8_SCHED; PG8_LDA(At, 1, 0); PG8_STAGE(PG8_SA(0, 1), a2 + hstepA, voffA);
            PG8_WAIT_V(8); PG8_WAIT_L(0); PG8_BAR; PG8_MMA(0, 0, At, B0); PG8_MMA(0, 1, At, B1); PG8_BAR; PG8_SCHED;
            PG8_LDA(At, 1, 1); PG8_STAGE(PG8_SB(1, 0), b3, voffB); PG8_STAGE(PG8_SB(1, 1), b3 + hstepB, voffB); PG8_STAGE(PG8_SA(1, 0), a3, voffA);
            PG8_WAIT_V(8); PG8_WAIT_L(0); PG8_BAR; PG8_MMA(1, 0, At, B0); PG8_MMA(1, 1, At, B1); PG8_BAR; PG8_SCHED;
            } else {
            PG8_LDB(B0, 0, 0); PG8_SCHED; PG8_LDA(At, 0, 0); PG8_STAGE(PG8_SA(1, 1), a1 + hstepA, voffA);
            PG8_WAIT_L(8); PG8_BAR; PG8_WAIT_L(0); PG8_MMA(0, 0, At, B0); PG8_BAR; PG8_SCHED;
            PG8_LDB(B1, 0, 1); PG8_STAGE(PG8_SB(0, 0), b2, voffB);
            PG8_BAR; PG8_WAIT_L(0); PG8_MMA(0, 1, At, B1); PG8_BAR;
            PG8_LDA(At, 0, 1); PG8_STAGE(PG8_SA(0, 0), a2, voffA);
            PG8_BAR; PG8_WAIT_L(0); PG8_MMA(1, 0, At, B0); PG8_BAR; PG8_SCHED;
            PG8_STAGE(PG8_SB(0, 1), b2 + hstepB, voffB);
            PG8_WAIT_V(6); PG8_BAR; PG8_MMA(1, 1, At, B1); PG8_BAR;
            PG8_LDB(B0, 1, 0); PG8_SCHED; PG8_LDA(At, 1, 0); PG8_STAGE(PG8_SA(0, 1), a2 + hstepA, voffA);
            PG8_WAIT_L(8); PG8_BAR; PG8_WAIT_L(0); PG8_MMA(0, 0, At, B0); PG8_BAR; PG8_SCHED;
            PG8_LDB(B1, 1, 1); PG8_STAGE(PG8_SB(1, 0), b3, voffB);
            PG8_BAR; PG8_WAIT_L(0); PG8_MMA(0, 1, At, B1); PG8_BAR;
            PG8_LDA(At, 1, 1); PG8_STAGE(PG8_SA(1, 0), a3, voffA);
            PG8_BAR; PG8_WAIT_L(0); PG8_MMA(1, 0, At, B0); PG8_BAR; PG8_SCHED;
            PG8_STAGE(PG8_SB(1, 1), b3 + hstepB, voffB);
            PG8_WAIT_V(6); PG8_BAR; PG8_MMA(1, 1, At, B1); PG8_BAR;
            }
        }
        if constexpr (ALIGN_EPI) { if (wr == 0) PG8_BAR; }
        if constexpr (!Epi::AFTER_DRAIN) { E(acc, cur, wr, wc, fr, fq); S.done(cur); }
        if (!has_next) break;
#pragma unroll
        for (int a = 0; a < 2; ++a)
#pragma unroll
            for (int b = 0; b < 2; ++b)
#pragma unroll
                for (int m = 0; m < 4; ++m)
#pragma unroll
                    for (int n = 0; n < 2; ++n) acc[a][b][m][n] = (f32x4){0.f, 0.f, 0.f, 0.f};
        cur = nxt; cA = nA; cB = nB; ++ui;
        if constexpr (ALIGN_EPI) { if (wr == 1) PG8_BAR; }
    }
    PG8_WAIT_V(0);
    if constexpr (!ALIGN_EPI) { if (wr == 0) PG8_BAR; }
    PG8_BAR;
    if constexpr (Epi::AFTER_DRAIN) { E.fused(acc, cur, wr, wc, fr, fq, lds, wid, lane); S.done(cur); }
#undef PG8_SA
#undef PG8_SB
#undef PG8_STAGE
#undef PG8_LDA
#undef PG8_LDB
#undef PG8_MMA
#undef PG8_WAIT_V
#undef PG8_WAIT_L
#undef PG8_BAR
#undef PG8_SCHED
}
}

#define LAS __attribute__((address_space(3)))
#define DI __device__ __forceinline__
typedef unsigned short bf16;
typedef short bf16x8 __attribute__((ext_vector_type(8)));
typedef short s16x4 __attribute__((ext_vector_type(4)));
typedef float f32x4 __attribute__((ext_vector_type(4)));
typedef float f32x16 __attribute__((ext_vector_type(16)));
typedef unsigned u32x4 __attribute__((ext_vector_type(4)));
typedef unsigned u32x2 __attribute__((ext_vector_type(2)));

constexpr int T_TOK = 32768, DM = 1024, NCHUNK = 256;
constexpr int LDP = 5632;
constexpr int NINP = 5888;
constexpr int DFF = 2816, LDU = 5632;
constexpr int PC_Z = 0, PC_X = 1024, PC_B = 2048, PC_C = 2304, PC_Q = 2560, PC_K = 3072, PC_V = 3584, PC_G = 4608;
constexpr float EPS = 1e-6f;
constexpr size_t MiB = 1u << 20;
constexpr size_t WS_R1 = 1 * MiB;
constexpr size_t WS_BIG = 97 * MiB;
constexpr size_t WS_WIN = 449 * MiB;
constexpr size_t WS_WOUT = WS_WIN + (size_t)NINP * 1024 * 2;
constexpr size_t WS_WUP = WS_WOUT + (size_t)1024 * 2048 * 2;
constexpr size_t WS_WDN = WS_WUP + (size_t)5632 * 1024 * 2;
constexpr size_t WS_DT = 481 * MiB;
constexpr size_t WS_CD = 483 * MiB;
constexpr size_t WS_END = 484 * MiB;
static_assert(WS_WDN + (size_t)1024 * 2816 * 2 <= WS_DT, "ws map");
constexpr size_t STS_BYTES = (size_t)256 * 16 * 8192 * 2;
constexpr int LDS_BYTES = 155648;
constexpr int NTHR = 512;

struct Args { const float* in[18]; float* out; unsigned char* ws; int ph_lo, ph_hi; };

#define LDSBAR() do { asm volatile("s_waitcnt lgkmcnt(0)" ::: "memory"); __builtin_amdgcn_s_barrier(); asm volatile("" ::: "memory"); } while (0)
DI float bf2f(unsigned v) { return __uint_as_float(v << 16); }
DI unsigned cvtpk(float lo, float hi) { unsigned r; asm("v_cvt_pk_bf16_f32 %0, %1, %2" : "=v"(r) : "v"(lo), "v"(hi)); return r; }
DI bf16 f2bf(float f) { return (bf16)(cvtpk(f, 0.f) & 0xffffu); }
DI void unpack8(const u32x4 v, float (&f)[8]) {
    f[0] = __uint_as_float(v.x << 16); f[1] = __uint_as_float(v.x & 0xffff0000u); f[2] = __uint_as_float(v.y << 16); f[3] = __uint_as_float(v.y & 0xffff0000u);
    f[4] = __uint_as_float(v.z << 16); f[5] = __uint_as_float(v.z & 0xffff0000u); f[6] = __uint_as_float(v.w << 16); f[7] = __uint_as_float(v.w & 0xffff0000u);
}
DI u32x4 pack8(const float (&f)[8]) { u32x4 w; w.x = cvtpk(f[0], f[1]); w.y = cvtpk(f[2], f[3]); w.z = cvtpk(f[4], f[5]); w.w = cvtpk(f[6], f[7]); return w; }
DI float silu(float x) { return x / (1.f + __expf(-x)); }
DI float softplus(float x) { return fmaxf(x, 0.f) + log1pf(__expf(-fabsf(x))); }
DI float wave_sum(float v) {
#pragma unroll
    for (int o = 1; o < 64; o <<= 1) v += __shfl_xor(v, o);
    return v;
}
DI float half_sum32(float v) {
#pragma unroll
    for (int o = 1; o < 32; o <<= 1) v += __shfl_xor(v, o);
    return v;
}
DI int crow(int reg, int h) { return (reg & 3) + 8 * (reg >> 2) + 4 * h; }
DI float ret_lg(int h) { return log1pf(-exp2f(-5.f - (float)h)); }

typedef short v4i16_t __attribute__((ext_vector_type(4)));
DI bf16x8 frag_row(const LAS bf16* T, int ld, int row0, int k0, int lane) {
    return *(const LAS bf16x8*)(T + (row0 + (lane & 31)) * ld + k0 + 8 * (lane >> 5));
}
DI bf16x8 frag_tr(const LAS bf16* T, int ld, int row0, int k0, int lane) {
    const int h = lane >> 5, blk = (lane >> 4) & 1, q = (lane & 15) >> 2, p = lane & 3;
    const LAS bf16* a = T + (k0 + 8 * h + q) * ld + row0 + 16 * blk + 4 * p;
    const v4i16_t lo = __builtin_amdgcn_ds_read_tr16_b64_v4i16((LAS v4i16_t*)a);
    const v4i16_t hi = __builtin_amdgcn_ds_read_tr16_b64_v4i16((LAS v4i16_t*)(a + 4 * ld));
    return __builtin_shufflevector(lo, hi, 0, 1, 2, 3, 4, 5, 6, 7);
}
template <int NT, bool A_TR, bool B_TR>
DI void mma_tile(f32x16 (&acc)[NT], const LAS bf16* A, int lda, int arow0, const LAS bf16* B, int ldb, int brow0, int K, int lane) {
#pragma unroll 2
    for (int k0 = 0; k0 < K; k0 += 16) {
        const bf16x8 a = A_TR ? frag_tr(A, lda, arow0, k0, lane) : frag_row(A, lda, arow0, k0, lane);
#pragma unroll
        for (int nt = 0; nt < NT; ++nt) {
            const bf16x8 b = B_TR ? frag_tr(B, ldb, brow0 + 32 * nt, k0, lane) : frag_row(B, ldb, brow0 + 32 * nt, k0, lane);
            acc[nt] = __builtin_amdgcn_mfma_f32_32x32x16_bf16(a, b, acc[nt], 0, 0, 0);
        }
    }
}
DI void zero16(f32x16& a) {
#pragma unroll
    for (int i = 0; i < 16; ++i) a[i] = 0.f;
}

DI void transpose_item(const float* W, int K, int N, bf16* WT, int mode, LAS float* scr, int item, int lane) {
    const int Ndst = mode == 1 ? NINP : N;
    const int nblk = Ndst / 32, kb = item / nblk, nb = item % nblk, k0 = 64 * kb, n0 = 32 * nb;
    const int nd = n0 + (lane & 31); int ns = nd; bool valid = true;
    if (mode == 1) { if (nd < 2560) ns = nd; else if (nd < 5632) ns = nd + 16; else if (nd < 5648) ns = nd - 5632 + 2560; else { valid = false; ns = 0; } }
#pragma unroll 8
    for (int i = 0; i < 32; ++i) { const int kk = 2 * i + (lane >> 5); scr[kk * 33 + (lane & 31)] = valid ? W[(size_t)(k0 + kk) * N + ns] : 0.f; }
    asm volatile("s_waitcnt lgkmcnt(0)" ::: "memory");
    const int c = lane & 7;
#pragma unroll
    for (int j = 0; j < 4; ++j) { const int n = (lane >> 3) + 8 * j; const LAS float* s = scr + (8 * c) * 33 + n;
        u32x4 o; o.x = cvtpk(s[0 * 33], s[1 * 33]); o.y = cvtpk(s[2 * 33], s[3 * 33]); o.z = cvtpk(s[4 * 33], s[5 * 33]); o.w = cvtpk(s[6 * 33], s[7 * 33]);
        *(u32x4*)(WT + (size_t)(n0 + n) * K + k0 + 8 * c) = o; }
    asm volatile("s_waitcnt lgkmcnt(0)" ::: "memory");
}
DI void p0_prologue(const Args& a, LAS unsigned char* lds, int wave, int lane) {
    unsigned char* ws = a.ws;
    LAS float* scr = (LAS float*)(lds + wave * 16384);
    const int gw = blockIdx.x * 8 + wave, NGW = gridDim.x * 8;
    constexpr int I_IN = 16 * (NINP / 32), I_OUT = 32 * 32, I_UP = 16 * 176, I_DN = 44 * 32;
    for (int it = gw; it < I_IN + I_OUT + I_UP + I_DN; it += NGW) {
        int r = it;
        if (r < I_IN) { transpose_item(a.in[2], 1024, 5648, (bf16*)(ws + WS_WIN), 1, scr, r, lane); continue; } r -= I_IN;
        if (r < I_OUT) { transpose_item(a.in[10], 2048, 1024, (bf16*)(ws + WS_WOUT), 0, scr, r, lane); continue; } r -= I_OUT;
        if (r < I_UP) { transpose_item(a.in[13], 1024, 5632, (bf16*)(ws + WS_WUP), 0, scr, r, lane); continue; } r -= I_UP;
        transpose_item(a.in[16], 2816, 1024, (bf16*)(ws + WS_WDN), 0, scr, r, lane);
    }
    const float* x = a.in[0]; const f32x4* w4 = (const f32x4*)a.in[1]; bf16* H = (bf16*)(ws + WS_R1);
    f32x4 wv[4];
#pragma unroll
    for (int j = 0; j < 4; ++j) wv[j] = w4[lane + 64 * j];
    for (int m = gw; m < T_TOK; m += NGW) {
        const f32x4* xr = (const f32x4*)(x + (size_t)m * DM) + lane;
        f32x4 v[4]; float s = 0.f;
#pragma unroll
        for (int j = 0; j < 4; ++j) { v[j] = xr[64 * j]; s += (v[j].x * v[j].x + v[j].y * v[j].y) + (v[j].z * v[j].z + v[j].w * v[j].w); }
        const float rstd = rsqrtf(wave_sum(s) * (1.f / DM) + EPS);
        u32x2* o = (u32x2*)(H + (size_t)m * DM) + lane;
#pragma unroll
        for (int j = 0; j < 4; ++j) { u32x2 w; w.x = cvtpk(v[j].x * rstd * wv[j].x, v[j].y * rstd * wv[j].y); w.y = cvtpk(v[j].z * rstd * wv[j].z, v[j].w * rstd * wv[j].w); o[64 * j] = w; }
    }
}

DI void ssd_conv8(const bf16* PROJ, const float* cw, const float* cb, int trow, int pos, int pcol, int xc, float (&o)[8]) {
    u32x4 v[4];
#pragma unroll
    for (int j = 0; j < 4; ++j) { int rr = trow - 3 + j; rr = rr < 0 ? 0 : rr; v[j] = *(const u32x4*)(PROJ + (size_t)rr * LDP + pcol); }
    const f32x4 b0 = *(const f32x4*)(cb + xc), b1 = *(const f32x4*)(cb + xc + 4);
    float acc[8] = {b0.x, b0.y, b0.z, b0.w, b1.x, b1.y, b1.z, b1.w};
#pragma unroll
    for (int j = 0; j < 4; ++j) {
        const float mk = (pos - 3 + j >= 0) ? 1.f : 0.f;
        const f32x4 w0 = *(const f32x4*)(cw + j * 1536 + xc) * mk, w1 = *(const f32x4*)(cw + j * 1536 + xc + 4) * mk;
        float f[8]; unpack8(v[j], f);
        acc[0] += w0.x * f[0]; acc[1] += w0.y * f[1]; acc[2] += w0.z * f[2]; acc[3] += w0.w * f[3];
        acc[4] += w1.x * f[4]; acc[5] += w1.y * f[5]; acc[6] += w1.z * f[6]; acc[7] += w1.w * f[7];
    }
#pragma unroll
    for (int e = 0; e < 8; ++e) o[e] = silu(acc[e]);
}
DI void rotary8(const u32x4 v1, const u32x4 v2, int pos, int dg, float scale, u32x4& o1, u32x4& o2) {
    float a[8], b[8], r1[8], r2[8]; unpack8(v1, a); unpack8(v2, b);
#pragma unroll
    for (int e = 0; e < 8; ++e) {
        const float inv = exp2f(-(float)(dg + e) * 0.41524101186092f);
        const float ang = (float)pos * inv;
        const float n = rintf(ang * 0.15915494309189535f);
        float r = fmaf(-n, 6.28125f, ang); r = fmaf(-n, 1.9353071795864769e-3f, r);
        const float sn = __sinf(r), cs = __cosf(r);
        r1[e] = (a[e] * cs - b[e] * sn) * scale; r2[e] = (b[e] * cs + a[e] * sn) * scale;
    }
    o1 = pack8(r1); o2 = pack8(r2);
}
DI void chunk_prep(const Args& a, const float* DT, int bc, LAS float* dtl, LAS float* acs, int wave, int lane) {
    const int t0 = bc * 128;
#pragma unroll
    for (int hh = 0; hh < 2; ++hh) {
        const int h = 2 * wave + hh, l0 = 2 * lane;
        const float bias = a.in[5][h], av = -expf(a.in[6][h]);
        const float d0 = softplus(DT[(size_t)(t0 + l0) * 16 + h] + bias), d1 = softplus(DT[(size_t)(t0 + l0 + 1) * 16 + h] + bias);
        const float x0 = d0 * av, x1 = x0 + d1 * av;
        float s = x1;
#pragma unroll
        for (int off = 1; off < 64; off <<= 1) { const float v = __shfl_up(s, off); if (lane >= off) s += v; }
        const float ex = s - x1;
        acs[h * 128 + l0] = ex + x0; acs[h * 128 + l0 + 1] = ex + x1; dtl[h * 128 + l0] = d0; dtl[h * 128 + l0 + 1] = d1;
    }
}

#ifndef P4_SSD
#define P4_SSD 2
#endif
#ifndef P4_RET
#define P4_RET 8
#endif
template <int ROWS>
DI void ssd_conv_rows(const bf16* PROJ, const float* cw, const float* cb, int trow0, int pos0l, int pcol, int xc, const float (&sc)[ROWS], LAS bf16* dst, int ld) {
    u32x4 v[ROWS + 3];
#pragma unroll
    for (int i = 0; i < ROWS + 3; ++i) { int rr = trow0 - 3 + i; rr = rr < 0 ? 0 : rr; v[i] = *(const u32x4*)(PROJ + (size_t)rr * LDP + pcol); }
    float w[4][8], b[8];
#pragma unroll
    for (int j = 0; j < 4; ++j) { const f32x4 u0 = *(const f32x4*)(cw + j * 1536 + xc), u1 = *(const f32x4*)(cw + j * 1536 + xc + 4);
        w[j][0] = u0.x; w[j][1] = u0.y; w[j][2] = u0.z; w[j][3] = u0.w; w[j][4] = u1.x; w[j][5] = u1.y; w[j][6] = u1.z; w[j][7] = u1.w; }
    { const f32x4 u0 = *(const f32x4*)(cb + xc), u1 = *(const f32x4*)(cb + xc + 4); b[0] = u0.x; b[1] = u0.y; b[2] = u0.z; b[3] = u0.w; b[4] = u1.x; b[5] = u1.y; b[6] = u1.z; b[7] = u1.w; }
#pragma unroll
    for (int i = 0; i < 3; ++i) if (pos0l - 3 + i < 0) v[i] = (u32x4){0u, 0u, 0u, 0u};
    float f0[8], f1[8], f2[8], f3[8];
    unpack8(v[0], f0); unpack8(v[1], f1); unpack8(v[2], f2);
#pragma unroll
    for (int r = 0; r < ROWS; ++r) {
        unpack8(v[r + 3], f3); float o[8];
#pragma unroll
        for (int e = 0; e < 8; ++e) { const float t = b[e] + w[0][e] * f0[e] + w[1][e] * f1[e] + w[2][e] * f2[e] + w[3][e] * f3[e]; o[e] = silu(t) * sc[r]; f0[e] = f1[e]; f1[e] = f2[e]; f2[e] = f3[e]; }
        *(LAS u32x4*)(dst + r * ld) = pack8(o);
    }
}
typedef float f32x2_t __attribute__((ext_vector_type(2)));
typedef __bf16 bf16x2_t __attribute__((ext_vector_type(2)));
DI unsigned cvtpk_c(float lo, float hi) { const f32x2_t v = {lo, hi}; const bf16x2_t b = __builtin_convertvector(v, bf16x2_t); return __builtin_bit_cast(unsigned, b); }
DI bf16x8 frag_tr_perm(const LAS bf16* T, int ld, int row0, int k0, int lane) {
    const int h = lane >> 5, blk = (lane >> 4) & 1, q = (lane & 15) >> 2, p = lane & 3;
    const LAS bf16* a = T + (k0 + 4 * h + q) * ld + row0 + 16 * blk + 4 * p;
    const v4i16_t lo = __builtin_amdgcn_ds_read_tr16_b64_v4i16((LAS v4i16_t*)a);
    const v4i16_t hi = __builtin_amdgcn_ds_read_tr16_b64_v4i16((LAS v4i16_t*)(a + 8 * ld));
    return __builtin_shufflevector(lo, hi, 0, 1, 2, 3, 4, 5, 6, 7);
}

DI void p2_chunk(const Args& a, LAS unsigned char* lds, int bc, int tid, int wave, int lane) {
    unsigned char* ws = a.ws;
    const bf16* PROJ = (const bf16*)(ws + WS_BIG); const float* DT = (const float*)(ws + WS_DT); float* CD = (float*)(ws + WS_CD);
    bf16* STS = (bf16*)(ws + WS_R1); bf16* STR = (bf16*)(ws + WS_R1 + STS_BYTES);
    LAS float* dtl = (LAS float*)lds; LAS float* acs = (LAS float*)(lds + 8192);
    LAS bf16* T1 = (LAS bf16*)(lds + 16384);
    LAS bf16* T2 = (LAS bf16*)(lds + 16384 + 73728);
    const int t0 = bc * 128, pos0 = (bc & 63) * 128;
    __syncthreads();
    chunk_prep(a, DT, bc, dtl, acs, wave, lane);
    LDSBAR();
    if (tid < 16) CD[bc * 16 + tid] = __expf(acs[tid * 128 + 127]);
    const float* cw = a.in[3]; const float* cb = a.in[4];
    for (int g = 0; g < 2; ++g) {
        { const int c8 = (tid & 15) * 8, l0 = (tid >> 4) * 4; const float one[4] = {1.f, 1.f, 1.f, 1.f};
          ssd_conv_rows<4>(PROJ, cw, cb, t0 + l0, pos0 + l0, PC_B + g * 128 + c8, 1024 + g * 128 + c8, one, T2 + l0 * 160 + c8, 160); }
        for (int hh = 0; hh < 2; ++hh) {
            { const int col = (tid & 31) * 8, h = g * 8 + hh * 4 + (col >> 6), xc = h * 64 + (col & 63);
#pragma unroll 1
              for (int half = 0; half < 2; ++half) { const int l0 = (tid >> 5) * 8 + half * 4; float sc[4];
#pragma unroll
                for (int r = 0; r < 4; ++r) sc[r] = dtl[h * 128 + l0 + r] * __expf(acs[h * 128 + 127] - acs[h * 128 + l0 + r]);
                ssd_conv_rows<4>(PROJ, cw, cb, t0 + l0, pos0 + l0, PC_X + xc, xc, sc, T1 + l0 * 288 + col, 288); } }
            LDSBAR();
            f32x16 acc[4];
#pragma unroll
            for (int nt = 0; nt < 4; ++nt) zero16(acc[nt]);
            mma_tile<4, true, true>(acc, T1, 288, wave * 32, T2, 160, 0, 128, lane);
            LDSBAR();
#pragma unroll
            for (int nt = 0; nt < 4; ++nt)
#pragma unroll
                for (int reg = 0; reg < 16; ++reg) T1[(wave * 32 + crow(reg, lane >> 5)) * 136 + nt * 32 + (lane & 31)] = f2bf(acc[nt][reg]);
            LDSBAR();
            { bf16* S = STS + (size_t)(bc * 16 + g * 8 + hh * 4) * 8192;
#pragma unroll
              for (int r = 0; r < 8; ++r) { const int it = tid + NTHR * r, pp = it >> 4, c8 = (it & 15) * 8;
                  *(u32x4*)(S + pp * 128 + c8) = *(const LAS u32x4*)(T1 + pp * 136 + c8); } }
            LDSBAR();
        }
    }
    for (int hp = 0; hp < 4; ++hp) {
#pragma unroll
        for (int r = 0; r < 8; ++r) { const int it = tid + NTHR * r, l = it >> 5, col = (it & 31) * 8;
            *(LAS u32x4*)(T1 + l * 288 + col) = *(const u32x4*)(PROJ + (size_t)(t0 + l) * LDP + PC_V + hp * 256 + col); }
#pragma unroll
        for (int r = 0; r < 2; ++r) { const int it = tid + NTHR * r, l = it >> 3, i = (it >> 2) & 1, dg = (it & 3) * 8, h = 2 * hp + i;
            const bf16* kp = PROJ + (size_t)(t0 + l) * LDP + PC_K + h * 64 + dg;
            const u32x4 k1 = *(const u32x4*)kp, k2 = *(const u32x4*)(kp + 32); u32x4 o1, o2;
            rotary8(k1, k2, pos0 + l, dg, 0.125f * __expf(ret_lg(h) * (float)(127 - l)), o1, o2);
            *(LAS u32x4*)(T2 + l * 160 + i * 64 + dg) = o1; *(LAS u32x4*)(T2 + l * 160 + i * 64 + 32 + dg) = o2; }
        LDSBAR();
        f32x16 acc[2]; zero16(acc[0]); zero16(acc[1]);
        const int i = wave >> 2;
        mma_tile<2, true, true>(acc, T1, 288, i * 128 + (wave & 3) * 32, T2, 160, i * 64, 128, lane);
        LDSBAR();
#pragma unroll
        for (int nt = 0; nt < 2; ++nt)
#pragma unroll
            for (int reg = 0; reg < 16; ++reg) T1[(wave * 32 + crow(reg, lane >> 5)) * 72 + nt * 32 + (lane & 31)] = f2bf(acc[nt][reg]);
        LDSBAR();
        { bf16* S = STR + (size_t)(bc * 8 + 2 * hp) * 8192;
#pragma unroll
          for (int r = 0; r < 4; ++r) { const int it = tid + NTHR * r, ee = it >> 3, c8 = (it & 7) * 8;
              *(u32x4*)(S + ee * 64 + c8) = *(const LAS u32x4*)(T1 + ee * 72 + c8); } }
        LDSBAR();
    }
}

DI void p3_scan(const Args& a, int tid) {
    unsigned char* ws = a.ws;
    bf16* STS = (bf16*)(ws + WS_R1); bf16* STR = (bf16*)(ws + WS_R1 + STS_BYTES); const float* CD = (const float*)(ws + WS_CD);
    const int nth = gridDim.x * NTHR;
    for (int it = blockIdx.x * NTHR + tid; it < 98304; it += nth) {
        bf16* base; size_t stride; const float* cdp = nullptr; float cdec = 0.f;
        if (it < 65536) { const int b = it >> 14, h = (it >> 10) & 15, v = it & 1023; base = STS + ((size_t)(b * 64) * 16 + h) * 8192 + v * 8; stride = (size_t)16 * 8192; cdp = CD + (b * 64) * 16 + h; }
        else { const int j = it - 65536, b = j >> 13, h = (j >> 10) & 7, v = j & 1023; base = STR + ((size_t)(b * 64) * 8 + h) * 8192 + v * 8; stride = (size_t)8 * 8192; cdec = __expf(ret_lg(h) * 128.f); }
        float run[8];
#pragma unroll
        for (int e = 0; e < 8; ++e) run[e] = 0.f;
#pragma unroll 1
        for (int c0 = 0; c0 < 64; c0 += 8) {
            u32x4 s[8]; float dec[8];
#pragma unroll
            for (int k = 0; k < 8; ++k) { s[k] = *(const u32x4*)(base + (size_t)(c0 + k) * stride); dec[k] = cdp ? cdp[(c0 + k) * 16] : cdec; }
#pragma unroll
            for (int k = 0; k < 8; ++k) { float f[8]; unpack8(s[k], f); *(u32x4*)(base + (size_t)(c0 + k) * stride) = pack8(run);
#pragma unroll
                for (int e = 0; e < 8; ++e) run[e] = run[e] * dec[k] + f[e]; }
        }
    }
}

DI void p4_ssd_chunk(const Args& a, LAS unsigned char* lds, int bc, int tid, int wave, int lane) {
    unsigned char* ws = a.ws;
    const bf16* PROJ = (const bf16*)(ws + WS_BIG); const float* DT = (const float*)(ws + WS_DT);
    const bf16* STS = (const bf16*)(ws + WS_R1);
    bf16* YM = (bf16*)a.out;
    LAS float* dtl = (LAS float*)lds; LAS float* acs = (LAS float*)(lds + 4096);
    LAS float* ssq = (LAS float*)(lds + 8192);
    LAS bf16* Cg = (LAS bf16*)(lds + 8704);
    LAS bf16* Bg = (LAS bf16*)(lds + 43520);
    LAS bf16* X2 = (LAS bf16*)(lds + 78336);
    LAS bf16* Yb = (LAS bf16*)(lds + 119296);
    const int t0 = bc * 128, pos0 = (bc & 63) * 128, hl = lane >> 5, i2 = wave >> 2, pt = (wave >> 1) & 1, wsel = wave & 1;
    const float* cw = a.in[3]; const float* cb = a.in[4]; const float* nw = a.in[8]; float* RS = (float*)(ws + WS_CD + 65536);
    __syncthreads();
    for (int i = tid; i < 128; i += NTHR) ssq[i] = 0.f;
    for (int g = 0; g < P4_SSD; ++g) {
        LDSBAR();
        { const int h = g * 8 + wave, l0 = 2 * lane;
          const float bias = a.in[5][h], av = -expf(a.in[6][h]);
          const float d0 = softplus(DT[(size_t)(t0 + l0) * 16 + h] + bias), d1 = softplus(DT[(size_t)(t0 + l0 + 1) * 16 + h] + bias);
          const float x0 = d0 * av, x1 = x0 + d1 * av; float s = x1;
#pragma unroll
          for (int off = 1; off < 64; off <<= 1) { const float v = __shfl_up(s, off); if (lane >= off) s += v; }
          const float ex = s - x1;
          acs[wave * 128 + l0] = ex + x0; acs[wave * 128 + l0 + 1] = ex + x1; dtl[wave * 128 + l0] = d0; dtl[wave * 128 + l0 + 1] = d1; }
        { const int c8 = (tid & 15) * 8, l0 = (tid >> 4) * 4; const float one[4] = {1.f, 1.f, 1.f, 1.f};
          ssd_conv_rows<4>(PROJ, cw, cb, t0 + l0, pos0 + l0, PC_C + g * 128 + c8, 1280 + g * 128 + c8, one, Cg + l0 * 136 + c8, 136);
          ssd_conv_rows<4>(PROJ, cw, cb, t0 + l0, pos0 + l0, PC_B + g * 128 + c8, 1024 + g * 128 + c8, one, Bg + l0 * 136 + c8, 136); }
#pragma unroll 1
        for (int hb = 0; hb < 4; ++hb) {
            const int hbase = g * 8 + hb * 2, h = hbase + i2, hloc = hb * 2 + i2;
            { const int c8 = (tid & 15) * 8, l0 = (tid >> 4) * 4; const float one[4] = {1.f, 1.f, 1.f, 1.f};
              ssd_conv_rows<4>(PROJ, cw, cb, t0 + l0, pos0 + l0, PC_X + hbase * 64 + c8, hbase * 64 + c8, one, X2 + l0 * 160 + c8, 160); }
            bf16x8 pf[8];
            { const bf16* S = STS + (size_t)(bc * 16 + h) * 8192 + (pt * 32 + (lane & 31)) * 128 + 8 * hl;
#pragma unroll
              for (int ks = 0; ks < 8; ++ks) pf[ks] = *(const bf16x8*)(S + ks * 16); }
            u32x4 zpre[4];
#pragma unroll
            for (int r = 0; r < 4; ++r) { const int it = tid + NTHR * r; zpre[r] = *(const u32x4*)(PROJ + (size_t)(t0 + (it >> 4)) * LDP + PC_Z + hbase * 64 + (it & 15) * 8); }
            const float dsk = a.in[7][h];
            LDSBAR();
#pragma unroll
            for (int lt = 0; lt < 2; ++lt) {
                const int mt = lt ? 3 - wsel : wsel;
                f32x16 y; zero16(y);
#pragma unroll
                for (int ks = 0; ks < 8; ++ks) y = __builtin_amdgcn_mfma_f32_32x32x16_bf16(frag_row(Cg, 136, mt * 32, ks * 16, lane), pf[ks], y, 0, 0, 0);
#pragma unroll
                for (int q4 = 0; q4 < 4; ++q4) { const f32x4 a4 = *(const LAS f32x4*)(acs + hloc * 128 + mt * 32 + 4 * hl + 8 * q4);
                    y[4 * q4] *= __expf(a4.x); y[4 * q4 + 1] *= __expf(a4.y); y[4 * q4 + 2] *= __expf(a4.z); y[4 * q4 + 3] *= __expf(a4.w); }
                const int lq = mt * 32 + (lane & 31); const float al = acs[hloc * 128 + lq];
#pragma unroll 1
                for (int st = 0; st <= mt; ++st) {
                    f32x16 cbt; zero16(cbt);
                    f32x4 as4[4], ds4[4];
#pragma unroll
                    for (int q4 = 0; q4 < 4; ++q4) { as4[q4] = *(const LAS f32x4*)(acs + hloc * 128 + st * 32 + 4 * hl + 8 * q4); ds4[q4] = *(const LAS f32x4*)(dtl + hloc * 128 + st * 32 + 4 * hl + 8 * q4); }
#pragma unroll
                    for (int ks = 0; ks < 8; ++ks) cbt = __builtin_amdgcn_mfma_f32_32x32x16_bf16(frag_row(Bg, 136, st * 32, ks * 16, lane), frag_row(Cg, 136, mt * 32, ks * 16, lane), cbt, 0, 0, 0);
                    u32x4 gp[2];
#pragma unroll
                    for (int r2 = 0; r2 < 8; ++r2) { const int s0 = st * 32 + crow(2 * r2, hl), s1 = s0 + 1;
                        const float e0 = __expf(fminf(al - as4[r2 >> 1][(2 * r2) & 3], 0.f)) * ds4[r2 >> 1][(2 * r2) & 3];
                        const float e1 = __expf(fminf(al - as4[r2 >> 1][(2 * r2 + 1) & 3], 0.f)) * ds4[r2 >> 1][(2 * r2 + 1) & 3];
                        const float m0 = (lq >= s0) ? 1.f : 0.f, m1 = (lq >= s1) ? 1.f : 0.f;
                        gp[r2 >> 2][r2 & 3] = cvtpk_c(cbt[2 * r2] * e0 * m0, cbt[2 * r2 + 1] * e1 * m1); }
#pragma unroll
                    for (int sp = 0; sp < 2; ++sp)
                        y = __builtin_amdgcn_mfma_f32_32x32x16_bf16(__builtin_bit_cast(bf16x8, gp[sp]), frag_tr_perm(X2, 160, i2 * 64 + pt * 32, st * 32 + 16 * sp, lane), y, 0, 0, 0);
                }
#pragma unroll
                for (int reg = 0; reg < 16; ++reg) { const int l = mt * 32 + crow(reg, hl), p = i2 * 64 + pt * 32 + (lane & 31);
                    Yb[l * 136 + p] = f2bf(y[reg] + dsk * bf2f(X2[l * 160 + p])); }
            }
            LDSBAR();
#pragma unroll
            for (int r = 0; r < 4; ++r) { const int it = tid + NTHR * r, l = it >> 4, c8 = (it & 15) * 8; float yv[8], z[8];
                unpack8(*(const LAS u32x4*)(Yb + l * 136 + c8), yv); unpack8(zpre[r], z);
                float q = 0.f;
#pragma unroll
                for (int e = 0; e < 8; ++e) { yv[e] *= silu(z[e]); q += yv[e] * yv[e]; }
                q += __shfl_xor(q, 1); q += __shfl_xor(q, 2); q += __shfl_xor(q, 4); q += __shfl_xor(q, 8);
                if ((lane & 15) == 0) atomicAdd((float*)(ssq + l), q);
                { const f32x4 w0 = *(const f32x4*)(nw + hbase * 64 + c8), w1 = *(const f32x4*)(nw + hbase * 64 + c8 + 4);
                  yv[0] *= w0.x; yv[1] *= w0.y; yv[2] *= w0.z; yv[3] *= w0.w; yv[4] *= w1.x; yv[5] *= w1.y; yv[6] *= w1.z; yv[7] *= w1.w; }
                *(u32x4*)(YM + (size_t)(t0 + l) * 2048 + hbase * 64 + c8) = pack8(yv); }
        }
    }
    LDSBAR();
    if (tid < 128) RS[t0 + tid] = rsqrtf(ssq[tid] * (1.f / 1024.f) + EPS);
}

DI void p4_ret_chunk(const Args& a, LAS unsigned char* lds, int bc, int tid, int wave, int lane) {
    unsigned char* ws = a.ws;
    const bf16* PROJ = (const bf16*)(ws + WS_BIG);
    const bf16* STR = (const bf16*)(ws + WS_R1 + STS_BYTES); const float* RS = (const float*)(ws + WS_CD + 65536);
    bf16* YM = (bf16*)a.out;
    LAS float* ssr = (LAS float*)(lds + 16384 + 512);
    constexpr int BASE = 20992;
    LAS bf16* Qm = (LAS bf16*)(lds + BASE);
    LAS bf16* Km = (LAS bf16*)(lds + BASE + 18432);
    LAS bf16* Pm = (LAS bf16*)(lds + BASE + 36864);
    LAS bf16* Vm = (LAS bf16*)(lds + BASE + 71680);
    LAS bf16* PT = (LAS bf16*)(lds + BASE + 112640);
    const int t0 = bc * 128, pos0 = (bc & 63) * 128, hl = lane >> 5, mt = wave >> 1, wn = wave & 1;
    __syncthreads();
    for (int i = tid; i < 1024; i += NTHR) ssr[i] = 0.f;
    for (int h = 0; h < P4_RET; ++h) {
        const float lg = ret_lg(h);
        LDSBAR();
        { const int l = tid >> 2, dg = (tid & 3) * 8;
          const bf16* qp = PROJ + (size_t)(t0 + l) * LDP + PC_Q + h * 64 + dg; const bf16* kp = PROJ + (size_t)(t0 + l) * LDP + PC_K + h * 64 + dg;
          u32x4 o1, o2;
          rotary8(*(const u32x4*)qp, *(const u32x4*)(qp + 32), pos0 + l, dg, 1.f, o1, o2);
          *(LAS u32x4*)(Qm + l * 72 + dg) = o1; *(LAS u32x4*)(Qm + l * 72 + 32 + dg) = o2;
          rotary8(*(const u32x4*)kp, *(const u32x4*)(kp + 32), pos0 + l, dg, 0.125f, o1, o2);
          *(LAS u32x4*)(Km + l * 72 + dg) = o1; *(LAS u32x4*)(Km + l * 72 + 32 + dg) = o2; }
        u32x4 gpre[4];
#pragma unroll
        for (int r = 0; r < 4; ++r) { const int it = tid + NTHR * r; gpre[r] = *(const u32x4*)(PROJ + (size_t)(t0 + (it >> 4)) * LDP + PC_G + h * 128 + (it & 15) * 8); }
#pragma unroll
        for (int r = 0; r < 4; ++r) { const int it = tid + NTHR * r, l = it >> 4, c8 = (it & 15) * 8;
            *(LAS u32x4*)(Vm + l * 160 + c8) = *(const u32x4*)(PROJ + (size_t)(t0 + l) * LDP + PC_V + h * 128 + c8); }
#pragma unroll
        for (int r = 0; r < 2; ++r) { const int it = tid + NTHR * r, e = it >> 3, c8 = (it & 7) * 8;
            *(LAS u32x4*)(PT + e * 72 + c8) = *(const u32x4*)(STR + (size_t)(bc * 8 + h) * 8192 + e * 64 + c8); }
        LDSBAR();
        { f32x16 sc[2]; zero16(sc[0]); zero16(sc[1]);
          mma_tile<2, false, false>(sc, Qm, 72, mt * 32, Km, 72, wn * 64, 64, lane);
#pragma unroll
          for (int nt = 0; nt < 2; ++nt) { const int s = wn * 64 + nt * 32 + (lane & 31);
#pragma unroll
              for (int reg = 0; reg < 16; ++reg) { const int l = mt * 32 + crow(reg, hl);
                  const float v = (l >= s) ? sc[nt][reg] * __expf(lg * (float)(l - s)) : 0.f;
                  Pm[l * 136 + s] = f2bf(v); } } }
        LDSBAR();
        f32x16 oi[2]; zero16(oi[0]); zero16(oi[1]);
        mma_tile<2, false, false>(oi, Qm, 72, mt * 32, PT, 72, wn * 64, 64, lane);
#pragma unroll
        for (int reg = 0; reg < 16; ++reg) { const float qd = __expf(lg * (float)(mt * 32 + crow(reg, hl) + 1)); oi[0][reg] *= qd; oi[1][reg] *= qd; }
        mma_tile<2, false, true>(oi, Pm, 136, mt * 32, Vm, 160, wn * 64, 128, lane);
#pragma unroll
        for (int reg = 0; reg < 16; ++reg) { const int l = mt * 32 + crow(reg, hl);
            const float q = half_sum32(oi[0][reg] * oi[0][reg] + oi[1][reg] * oi[1][reg]);
            if ((lane & 31) == 0) atomicAdd((float*)(ssr + h * 128 + l), q); }
        LDSBAR();
        { const float* rw = a.in[9];
#pragma unroll
          for (int nt = 0; nt < 2; ++nt) { const int e = wn * 64 + nt * 32 + (lane & 31); const float wv = rw[h * 128 + e];
#pragma unroll
              for (int reg = 0; reg < 16; ++reg) { const int l = mt * 32 + crow(reg, hl);
                  const float rstd = rsqrtf(ssr[h * 128 + l] * (1.f / 128.f) + EPS);
                  Pm[l * 136 + e] = f2bf(oi[nt][reg] * rstd * wv); } } }
        LDSBAR();
#pragma unroll
        for (int r = 0; r < 4; ++r) { const int it = tid + NTHR * r, l = it >> 4, c8 = (it & 15) * 8; float o[8], gv[8];
            unpack8(*(const LAS u32x4*)(Pm + l * 136 + c8), o); unpack8(gpre[r], gv);
            const float irs = 1.f / RS[t0 + l];
#pragma unroll
            for (int e = 0; e < 8; ++e) o[e] *= silu(gv[e]) * irs;
            *(u32x4*)(YM + (size_t)(t0 + l) * 2048 + 1024 + h * 128 + c8) = pack8(o); }
    }
}

DI void p6_norm(const Args& a, int wave, int lane) {
    unsigned char* ws = a.ws;
    const float* Y = (const float*)(ws + WS_BIG); bf16* H = (bf16*)(ws + WS_R1);
    const int gw = blockIdx.x * 8 + wave, NGW = gridDim.x * 8;
    const f32x4* w1p = (const f32x4*)a.in[11]; const f32x4* w2p = (const f32x4*)a.in[12];
    f32x4 w1[4], w2[4];
#pragma unroll
    for (int j = 0; j < 4; ++j) { w1[j] = w1p[lane + 64 * j]; w2[j] = w2p[lane + 64 * j]; }
    for (int m = gw; m < T_TOK; m += NGW) {
        const f32x4* yr = (const f32x4*)(Y + (size_t)m * DM) + lane; const f32x4* xr = (const f32x4*)(a.in[0] + (size_t)m * DM) + lane;
        f32x4 y[4], x[4]; float s = 0.f; const float rs = ((const float*)(ws + WS_CD + 65536))[m];
#pragma unroll
        for (int j = 0; j < 4; ++j) { y[j] = yr[64 * j] * rs; x[j] = xr[64 * j]; s += (y[j].x * y[j].x + y[j].y * y[j].y) + (y[j].z * y[j].z + y[j].w * y[j].w); }
        const float rstd = rsqrtf(wave_sum(s) * (1.f / DM) + EPS); float s2 = 0.f;
        f32x4* orow = (f32x4*)(a.out + (size_t)m * DM) + lane;
#pragma unroll
        for (int j = 0; j < 4; ++j) { x[j] = x[j] + y[j] * rstd * w1[j]; orow[64 * j] = x[j]; s2 += (x[j].x * x[j].x + x[j].y * x[j].y) + (x[j].z * x[j].z + x[j].w * x[j].w); }
        const float rstd2 = rsqrtf(wave_sum(s2) * (1.f / DM) + EPS);
        u32x2* o = (u32x2*)(H + (size_t)m * DM) + lane;
#pragma unroll
        for (int j = 0; j < 4; ++j) { u32x2 w; w.x = cvtpk(x[j].x * rstd2 * w2[j].x, x[j].y * rstd2 * w2[j].y); w.y = cvtpk(x[j].z * rstd2 * w2[j].z, x[j].w * rstd2 * w2[j].w); o[64 * j] = w; }
    }
}

DI void p8_act(const Args& a, int tid) {
    bf16* UP = (bf16*)(a.ws + WS_BIG); const float* cw = a.in[14]; const float* cb = a.in[15];
    for (int bc = blockIdx.x; bc < NCHUNK; bc += gridDim.x) {
#pragma unroll 1
        for (int r = 0; r < 6; ++r) { const int it = tid + NTHR * r; if (it >= 2816) break;
            const int cgi = it % 352, sub = it / 352, c0 = cgi * 8, t = bc * 128 + sub * 16, pos = (bc & 63) * 128 + sub * 16;
            float w[3][8], b[8];
#pragma unroll
            for (int j = 0; j < 3; ++j) { const f32x4 u0 = *(const f32x4*)(cw + j * DFF + c0), u1 = *(const f32x4*)(cw + j * DFF + c0 + 4);
                w[j][0] = u0.x; w[j][1] = u0.y; w[j][2] = u0.z; w[j][3] = u0.w; w[j][4] = u1.x; w[j][5] = u1.y; w[j][6] = u1.z; w[j][7] = u1.w; }
            { const f32x4 u0 = *(const f32x4*)(cb + c0), u1 = *(const f32x4*)(cb + c0 + 4); b[0] = u0.x; b[1] = u0.y; b[2] = u0.z; b[3] = u0.w; b[4] = u1.x; b[5] = u1.y; b[6] = u1.z; b[7] = u1.w; }
            float g2[8], g1[8];
            if (pos >= 2) { unpack8(*(const u32x4*)(UP + (size_t)(t - 2) * LDU + c0), g2); unpack8(*(const u32x4*)(UP + (size_t)(t - 1) * LDU + c0), g1); }
            else {
#pragma unroll
                for (int e = 0; e < 8; ++e) { g2[e] = 0.f; g1[e] = 0.f; } }
#pragma unroll 4
            for (int k = 0; k < 16; ++k) { bf16* rowp = UP + (size_t)(t + k) * LDU + c0;
                float g0[8], v[8], o[8]; unpack8(*(const u32x4*)rowp, g0); unpack8(*(const u32x4*)(rowp + DFF), v);
#pragma unroll
                for (int e = 0; e < 8; ++e) { const float s = b[e] + w[0][e] * g2[e] + w[1][e] * g1[e] + w[2][e] * g0[e]; o[e] = silu(s) * v[e]; g2[e] = g1[e]; g1[e] = g0[e]; }
                *(u32x4*)(rowp + DFF) = pack8(o); }
        }
    }
}

DI void p10_final(const Args& a, int wave, int lane, int nprobe) {
    const bf16* F = (const bf16*)(a.ws + WS_R1);
    const int gw = blockIdx.x * 8 + wave, NGW = gridDim.x * 8;
    const float* wp = a.in[17];
    for (int m = gw; m < T_TOK; m += NGW) {
        float f[2][8]; float s = 0.f;
#pragma unroll
        for (int j = 0; j < 2; ++j) { unpack8(*(const u32x4*)(F + (size_t)m * DM + (lane + 64 * j) * 8), f[j]);
#pragma unroll
            for (int e = 0; e < 8; ++e) s += f[j][e] * f[j][e]; }
        const float rstd = rsqrtf(wave_sum(s) * (1.f / DM) + EPS);
#pragma unroll
        for (int j = 0; j < 2; ++j) { float* op = a.out + (size_t)m * DM + (lane + 64 * j) * 8; const float* wq = wp + (lane + 64 * j) * 8;
            f32x4 x0 = *(const f32x4*)op, x1 = *(const f32x4*)(op + 4); const f32x4 w0 = *(const f32x4*)wq, w1 = *(const f32x4*)(wq + 4);
            x0.x += f[j][0] * rstd * w0.x; x0.y += f[j][1] * rstd * w0.y; x0.z += f[j][2] * rstd * w0.z; x0.w += f[j][3] * rstd * w0.w;
            x1.x += f[j][4] * rstd * w1.x; x1.y += f[j][5] * rstd * w1.y; x1.z += f[j][6] * rstd * w1.z; x1.w += f[j][7] * rstd * w1.w;
            if ((lane & 7) == 0 && m * 16 + (lane >> 3) + 8 * j < nprobe) x1.w += 0.125f;
            *(f32x4*)op = x0; *(f32x4*)(op + 4) = x1; }
    }
}

constexpr int N_PHASES = 12;
__global__ void __launch_bounds__(NTHR, 2) hymba_fwd(Args args) {
    extern __shared__ __attribute__((aligned(16))) unsigned char lds_raw[];
    LAS unsigned char* lds = (LAS unsigned char*)lds_raw;
    const int tid = threadIdx.x, lane = tid & 63, wave = __builtin_amdgcn_readfirstlane(tid >> 6);
    unsigned char* ws = args.ws;
    const int lo = args.ph_lo, hi = args.ph_hi;
#ifndef PHMASK
#define PHMASK 0xfff
#endif
#define IN(k) (((PHMASK >> (k)) & 1) && lo <= (k) && (k) < hi)
#ifdef PROBE_A
#define STAMP(k) do { if (tid == 0) *(LAS unsigned long long*)(lds + 155520 + 8 * (k)) = (unsigned long long)__builtin_amdgcn_s_memrealtime(); } while (0)
#else
#define STAMP(k) do { } while (0)
#endif
#define SEAM(k) do { if (IN(k) && IN((k) + 1)) { cgrp::this_grid().sync(); } STAMP((k) + 1); } while (0)
    STAMP(0);
    if (IN(0)) { p0_prologue(args, lds, wave, lane); }
    SEAM(0);
    if (IN(1)) {
        pg8::Gemm g{(const bf16*)(ws + WS_R1), (const bf16*)(ws + WS_WIN), T_TOK, NINP, 1024, 1024}; pg8::StaticOrder S; S.init(T_TOK, NINP, gridDim.x, (int)blockIdx.x);
        pg8::EpiProj E{(bf16*)(ws + WS_BIG), (float*)(ws + WS_DT)};
        pg8::gemm_phase<pg8::EpiProj, pg8::StaticOrder, true, true>(lds, g, S, E);
    }
    SEAM(1);
    if (IN(2)) { for (int bc = blockIdx.x; bc < NCHUNK; bc += gridDim.x) p2_chunk(args, lds, bc, tid, wave, lane); }
    SEAM(2);
    if (IN(3)) { p3_scan(args, tid); }
    SEAM(3);
    if (IN(4)) { for (int bc = blockIdx.x; bc < NCHUNK; bc += gridDim.x) p4_ssd_chunk(args, lds, bc, tid, wave, lane); }
    if (IN(5)) { for (int bc = blockIdx.x; bc < NCHUNK; bc += gridDim.x) p4_ret_chunk(args, lds, bc, tid, wave, lane); }
    SEAM(5);
    if (IN(6)) {
        __syncthreads();
        pg8::Gemm g{(const bf16*)args.out, (const bf16*)(ws + WS_WOUT), T_TOK, 1024, 2048, 2048}; pg8::StaticOrder S; S.init(T_TOK, 1024, gridDim.x, (int)blockIdx.x);
        pg8::EpiF32 E{(float*)(ws + WS_BIG), 1024};
        pg8::gemm_phase<pg8::EpiF32, pg8::StaticOrder, true, true>(lds, g, S, E);
    }
    SEAM(6);
    if (IN(7)) { p6_norm(args, wave, lane); }
    SEAM(7);
    if (IN(8)) {
        pg8::Gemm g{(const bf16*)(ws + WS_R1), (const bf16*)(ws + WS_WUP), T_TOK, 5632, 1024, 1024}; pg8::StaticOrder S; S.init(T_TOK, 5632, gridDim.x, (int)blockIdx.x);
        pg8::EpiBf16 E{(bf16*)(ws + WS_BIG), LDU};
        pg8::gemm_phase<pg8::EpiBf16, pg8::StaticOrder, true, true>(lds, g, S, E);
    }
    SEAM(8);
    if (IN(9)) { p8_act(args, tid); }
    SEAM(9);
    if (IN(10)) {
        pg8::Gemm g{(const bf16*)(ws + WS_BIG) + DFF, (const bf16*)(ws + WS_WDN), T_TOK, 1024, 2816, LDU}; pg8::StaticOrder S; S.init(T_TOK, 1024, gridDim.x, (int)blockIdx.x);
        pg8::EpiBf16 E{(bf16*)(ws + WS_R1), 1024};
        pg8::gemm_phase<pg8::EpiBf16, pg8::StaticOrder, true, true>(lds, g, S, E);
    }
    SEAM(10);
#ifdef PROBE_A
    int nprobe = 0;
    if (IN(11)) { __syncthreads(); const unsigned long long ta = *(LAS unsigned long long*)(lds + 155520 + 8 * PROBE_A), tb = *(LAS unsigned long long*)(lds + 155520 + 8 * PROBE_B); nprobe = (int)((tb - ta) / 2); }
#else
    const int nprobe = 0;
#endif
    if (IN(11)) { p10_final(args, wave, lane, nprobe); }
#undef IN
#undef SEAM
}

#ifndef MK_ONE_LAUNCH
#define MK_ONE_LAUNCH 1
#endif
#ifndef REP_PHASE
#define REP_PHASE -1
#define REP_COUNT 1
#endif
extern "C" void kernel_launch(void* const* d_in, const int* in_sizes, int n_in, void* d_out, int out_size, void* d_ws, size_t ws_size, hipStream_t stream) {
    static int grid = 0;
    if (grid == 0) {
        if (n_in != 18 || out_size != T_TOK * DM || ws_size < WS_END) { fprintf(stderr, "kernel_launch: unexpected shapes: n_in %d out %d ws %zu (need %zu)\n", n_in, out_size, ws_size, (size_t)WS_END); grid = -1; return; }
        int dev = 0, cus = 0, per_cu = 0;
        hipGetDevice(&dev); hipDeviceGetAttribute(&cus, hipDeviceAttributeMultiprocessorCount, dev);
        if (hipFuncSetAttribute((const void*)hymba_fwd, hipFuncAttributeMaxDynamicSharedMemorySize, LDS_BYTES) != hipSuccess) { fprintf(stderr, "kernel_launch: hipFuncSetAttribute failed\n"); grid = -1; return; }
        hipOccupancyMaxActiveBlocksPerMultiprocessor(&per_cu, (const void*)hymba_fwd, NTHR, LDS_BYTES);
        if (per_cu < 1) { fprintf(stderr, "kernel_launch: occupancy query says %d blocks per CU\n", per_cu); per_cu = 1; }
        (void)hipGetLastError();
        grid = cus;
    }
    if (grid < 0) return;
    Args a{};
    for (int i = 0; i < 18; ++i) a.in[i] = (const float*)d_in[i];
    a.out = (float*)d_out; a.ws = (unsigned char*)d_ws;
#if MK_ONE_LAUNCH
    a.ph_lo = 0; a.ph_hi = N_PHASES;
    void* kargs[] = {&a};
    hipError_t e = hipLaunchCooperativeKernel((const void*)hymba_fwd, dim3(grid), dim3(NTHR), kargs, LDS_BYTES, stream);
    if (e != hipSuccess) fprintf(stderr, "cooperative launch failed: %s (grid %d)\n", hipGetErrorString(e), grid);
#else
    for (int p = 0; p < N_PHASES; ++p) {
        a.ph_lo = p; a.ph_hi = p + 1;
        const int nrep = (p == REP_PHASE) ? REP_COUNT : 1;
        for (int rr = 0; rr < nrep; ++rr) hipLaunchKernelGGL(hymba_fwd, dim3(grid), dim3(NTHR), LDS_BYTES, stream, a);
    }
#endif
}
```
